# Optimizing an MI355X kernel written in HIP

```python
import jax, jax.numpy as jnp
from jax import lax
import numpy as np

D_MODEL = 1024
BATCH = 1
SEQ = 16384
DEPTH = 1
DEC_BATCH = 8
DEC_SEQ = 2048
PAST_LEN = 128

MIX_WIDTH = D_MODEL
GLA_WIDTH = MIX_WIDTH // 2
CONV_WIDTH = MIX_WIDTH - GLA_WIDTH
GLA_HEADS = 4
GLA_DV = GLA_WIDTH // GLA_HEADS
GLA_KEY_WIDTH = GLA_WIDTH // 2
GLA_DK = GLA_KEY_WIDTH // GLA_HEADS
GATE_RANK = 16
GATE_TAU = 16.0
CHUNK = 64
CONV_GROUPS = 8
CONV_GROUP_DIM = CONV_WIDTH // CONV_GROUPS
CONV_K = 3
D_FF = 2816
FFN_RESIDUAL = 0.5
EPS = 1e-6
IN_SPLIT_SIZES = (GLA_KEY_WIDTH, GLA_KEY_WIDTH, GLA_WIDTH, GLA_WIDTH,
                  GATE_RANK, GATE_RANK, CONV_WIDTH, CONV_WIDTH, CONV_WIDTH)
N_IN = 2 * GLA_KEY_WIDTH + 2 * GLA_WIDTH + 2 * GATE_RANK + 3 * CONV_WIDTH

kernel_name = "hybrid_gla_shortconv_macaron_encoder"


def rms_norm(x, gain):
    xf = x.astype(jnp.float32)
    inv = lax.rsqrt(jnp.mean(xf * xf, axis=-1, keepdims=True) + EPS)
    return (xf * inv).astype(x.dtype) * gain


def swiglu(x, w_gate, w_up, w_down):
    return (jax.nn.silu(x @ w_gate) * (x @ w_up)) @ w_down


def gla_chunked(q, k, v, log_a):
    bsz, nh, seq_len, dk = q.shape
    dv = v.shape[-1]
    n_chunks = seq_len // CHUNK

    def to_chunks(t):
        return t.reshape(bsz, nh, n_chunks, CHUNK, t.shape[-1]).transpose(2, 0, 1, 3, 4)

    qc, kc, vc, ac = (to_chunks(t) for t in (q, k, v, log_a))
    cum = jnp.cumsum(ac, axis=3)
    total = cum[:, :, :, -1:, :]
    q_dec = qc * jnp.exp(cum)
    k_inv = kc * jnp.exp(-cum)
    k_tail = kc * jnp.exp(total - cum)
    causal_in_chunk = jnp.tril(jnp.ones((CHUNK, CHUNK), dtype=bool))
    scores = jnp.einsum('nbhid,nbhjd->nbhij', q_dec, k_inv)
    intra = jnp.einsum('nbhij,nbhjv->nbhiv', jnp.where(causal_in_chunk, scores, 0.0), vc)

    def step(state, inp):
        qd, kt, vv, tot = inp
        out = jnp.einsum('bhid,bhdv->bhiv', qd, state)
        state = state * jnp.exp(tot[:, :, 0, :])[..., None] + jnp.einsum('bhjd,bhjv->bhdv', kt, vv)
        return state, out

    s0 = jnp.zeros((bsz, nh, dk, dv), jnp.float32)
    _, inter = lax.scan(step, s0, (q_dec, k_tail, vc, total))
    o = intra + inter
    return o.transpose(1, 2, 0, 3, 4).reshape(bsz, nh, seq_len, dv)


def bidirectional_gla(q, k, v, log_a_fwd, log_a_bwd):
    flip = lambda t: jnp.flip(t, axis=2)
    fwd = gla_chunked(q, k, v, log_a_fwd)
    bwd = flip(gla_chunked(flip(q), flip(k), flip(v), flip(log_a_bwd)))
    return fwd + bwd


def token_mixer(u, w_in, gate_fwd_w, gate_fwd_b, gate_bwd_w, gate_bwd_b,
                gla_head_norm, conv_w, conv_group_norm, w_out):
    bsz, seq_len, _ = u.shape
    split_points = np.cumsum(IN_SPLIT_SIZES)[:-1].tolist()
    q, k, v, g, r_f, r_b, b_gate, c_gate, h_in = jnp.split(u @ w_in, split_points, axis=-1)

    def heads(t, d):
        return t.reshape(bsz, seq_len, GLA_HEADS, d).transpose(0, 2, 1, 3).astype(jnp.float32)

    qh = heads(q, GLA_DK) * (GLA_DK ** -0.5)
    kh = heads(k, GLA_DK)
    vh = heads(v, GLA_DV)
    log_a_f = heads(jax.nn.log_sigmoid((r_f @ gate_fwd_w + gate_fwd_b).astype(jnp.float32)), GLA_DK) / GATE_TAU
    log_a_b = heads(jax.nn.log_sigmoid((r_b @ gate_bwd_w + gate_bwd_b).astype(jnp.float32)), GLA_DK) / GATE_TAU
    o = bidirectional_gla(qh, kh, vh, log_a_f, log_a_b)
    o = o * lax.rsqrt(jnp.mean(o * o, axis=-1, keepdims=True) + EPS)
    o = o.transpose(0, 2, 1, 3).reshape(bsz, seq_len, GLA_WIDTH).astype(u.dtype)
    gla_out = o * gla_head_norm * jax.nn.silu(g)

    z = c_gate * h_in
    pad = CONV_K // 2
    zp = jnp.pad(z, ((0, 0), (pad, pad), (0, 0)))
    conv = sum(zp[:, i:i + seq_len] * conv_w[i] for i in range(CONV_K))
    yc = (b_gate * conv).reshape(bsz, seq_len, CONV_GROUPS, CONV_GROUP_DIM).astype(jnp.float32)
    yc = yc * lax.rsqrt(jnp.mean(yc * yc, axis=-1, keepdims=True) + EPS)
    conv_out = yc.reshape(bsz, seq_len, CONV_WIDTH).astype(u.dtype) * conv_group_norm

    return jnp.concatenate([gla_out, conv_out], axis=-1) @ w_out


def encoder_layer(x, ffn1_norm, ffn1_w_gate, ffn1_w_up, ffn1_w_down, mix_norm, w_in,
                  gate_fwd_w, gate_fwd_b, gate_bwd_w, gate_bwd_b, gla_head_norm,
                  conv_w, conv_group_norm, w_out, ffn2_norm, ffn2_w_gate, ffn2_w_up, ffn2_w_down):
    x = x + FFN_RESIDUAL * swiglu(rms_norm(x, ffn1_norm), ffn1_w_gate, ffn1_w_up, ffn1_w_down)
    x = x + token_mixer(rms_norm(x, mix_norm), w_in, gate_fwd_w, gate_fwd_b, gate_bwd_w, gate_bwd_b,
                        gla_head_norm, conv_w, conv_group_norm, w_out)
    x = x + FFN_RESIDUAL * swiglu(rms_norm(x, ffn2_norm), ffn2_w_gate, ffn2_w_up, ffn2_w_down)
    return x


def trunk(x, layer_params, final_norm):
    for l in range(DEPTH):
        x = encoder_layer(x, *[p[l] for p in layer_params])
    return rms_norm(x, final_norm)


def setup_inputs(seed: int = 0) -> dict:
    key = jax.random.key(seed)
    ks = jax.random.split(key, 24)
    f32 = jnp.float32
    nrm = lambda k, shape, scale: jax.random.normal(k, shape, f32) * scale
    gain = lambda k, shape: 1.0 + 0.02 * jax.random.normal(k, shape, f32)
    return {
        "x_prompt": jax.random.normal(ks[0], (BATCH, SEQ, D_MODEL), f32),
        "x_sample": jax.random.normal(ks[1], (DEC_BATCH, DEC_SEQ, D_MODEL), f32),
        "ffn1_norm": gain(ks[2], (DEPTH, D_MODEL)),
        "ffn1_w_gate": nrm(ks[3], (DEPTH, D_MODEL, D_FF), D_MODEL ** -0.5),
        "ffn1_w_up": nrm(ks[4], (DEPTH, D_MODEL, D_FF), D_MODEL ** -0.5),
        "ffn1_w_down": nrm(ks[5], (DEPTH, D_FF, D_MODEL), D_FF ** -0.5),
        "mix_norm": gain(ks[6], (DEPTH, D_MODEL)),
        "w_in": nrm(ks[7], (DEPTH, D_MODEL, N_IN), D_MODEL ** -0.5),
        "gate_fwd_w": nrm(ks[8], (DEPTH, GATE_RANK, GLA_KEY_WIDTH), GATE_RANK ** -0.5),
        "gate_fwd_b": nrm(ks[9], (DEPTH, GLA_KEY_WIDTH), 0.1),
        "gate_bwd_w": nrm(ks[10], (DEPTH, GATE_RANK, GLA_KEY_WIDTH), GATE_RANK ** -0.5),
        "gate_bwd_b": nrm(ks[11], (DEPTH, GLA_KEY_WIDTH), 0.1),
        "gla_head_norm": gain(ks[12], (DEPTH, GLA_WIDTH)),
        "conv_w": nrm(ks[13], (DEPTH, CONV_K, CONV_WIDTH), CONV_K ** -0.5),
        "conv_group_norm": gain(ks[14], (DEPTH, CONV_WIDTH)),
        "w_out": nrm(ks[15], (DEPTH, MIX_WIDTH, D_MODEL), MIX_WIDTH ** -0.5),
        "ffn2_norm": gain(ks[16], (DEPTH, D_MODEL)),
        "ffn2_w_gate": nrm(ks[17], (DEPTH, D_MODEL, D_FF), D_MODEL ** -0.5),
        "ffn2_w_up": nrm(ks[18], (DEPTH, D_MODEL, D_FF), D_MODEL ** -0.5),
        "ffn2_w_down": nrm(ks[19], (DEPTH, D_FF, D_MODEL), D_FF ** -0.5),
        "final_norm": gain(ks[20], (D_MODEL,)),
    }


def reference(x_prompt, x_sample, ffn1_norm, ffn1_w_gate, ffn1_w_up, ffn1_w_down, mix_norm,
              w_in, gate_fwd_w, gate_fwd_b, gate_bwd_w, gate_bwd_b, gla_head_norm, conv_w,
              conv_group_norm, w_out, ffn2_norm, ffn2_w_gate, ffn2_w_up, ffn2_w_down, final_norm):
    layer_params = (ffn1_norm, ffn1_w_gate, ffn1_w_up, ffn1_w_down, mix_norm, w_in,
                    gate_fwd_w, gate_fwd_b, gate_bwd_w, gate_bwd_b, gla_head_norm,
                    conv_w, conv_group_norm, w_out, ffn2_norm, ffn2_w_gate, ffn2_w_up, ffn2_w_down)
    y_prompt = trunk(x_prompt, layer_params, final_norm)
    y_sample = trunk(x_sample, layer_params, final_norm)
    return (y_prompt, y_sample)
```

```cpp
#include <hip/hip_runtime.h>
#include <hip/hip_cooperative_groups.h>
#include <cstdio>
#include <cstdint>
namespace cg = cooperative_groups;

#define LAS __attribute__((address_space(3)))
typedef unsigned short bf16_t;
typedef short bf16x8 __attribute__((ext_vector_type(8)));
typedef float f32x4 __attribute__((ext_vector_type(4)));
typedef unsigned u32x4 __attribute__((ext_vector_type(4)));
typedef unsigned u32x2 __attribute__((ext_vector_type(2)));

constexpr int T_TOK = 32768, T_PROMPT = 16384, SAMPLE_LEN = 2048, DM = 1024, DFF = 2816, NIN_PAD = 3328;
constexpr int PLD = 2560;
constexpr int PQ = 0, PK = 256, PV = 512, PG = 1024, PZ = 1536, PB = 2048;
constexpr int NCHUNK = 512;
constexpr float EPS = 1e-6f;
constexpr size_t WS_WGU1 = 0;
constexpr size_t WS_WD1 = WS_WGU1 + (size_t)2 * DFF * DM * 2;
constexpr size_t WS_WIN = WS_WD1 + (size_t)DM * DFF * 2;
constexpr size_t WS_WOUT = WS_WIN + (size_t)NIN_PAD * DM * 2;
constexpr size_t WS_WGU2 = WS_WOUT + (size_t)DM * DM * 2;
constexpr size_t WS_WD2 = WS_WGU2 + (size_t)2 * DFF * DM * 2;
constexpr size_t WS_SS = WS_WD2 + (size_t)DM * DFF * 2;
constexpr size_t WS_DEC = WS_SS + (size_t)4 * T_TOK * 16 * 4;
constexpr size_t WS_R = WS_DEC + (size_t)NCHUNK * 4 * 2 * 64 * 4;
constexpr size_t WS_XB = WS_R + (size_t)T_TOK * 32 * 4;
constexpr size_t WS_H = WS_XB + (size_t)T_TOK * DM * 2;
constexpr size_t WS_P = WS_H + (size_t)T_TOK * DFF * 2;
constexpr size_t WS_BAR = WS_P + (size_t)T_TOK * PLD * 2;
constexpr size_t WS_END = WS_BAR + 16384;
constexpr size_t WS_MIX = WS_H;
constexpr size_t WS_ST = WS_H + (size_t)T_TOK * DM * 2;
static_assert(WS_ST + (size_t)NCHUNK * 4 * 2 * 8192 * 2 <= WS_P, "overlay");

struct Params {
    const float *x_prompt, *x_sample, *ffn1_norm, *ffn1_wg, *ffn1_wu, *ffn1_wd, *mix_norm, *w_in, *gfw, *gfb, *gbw, *gbb, *gla_norm, *conv_w, *conv_norm, *w_out,
        *ffn2_norm, *ffn2_wg, *ffn2_wu, *ffn2_wd, *final_norm;
    float* out; unsigned char* ws;
    int ph_lo, ph_hi;
};

typedef float f32x2_t __attribute__((ext_vector_type(2)));
typedef __bf16 bf16x2_t __attribute__((ext_vector_type(2)));
__device__ __forceinline__ unsigned cvt_pk_bf16(float lo, float hi) { const f32x2_t v = {lo, hi}; const bf16x2_t b = __builtin_convertvector(v, bf16x2_t); return __builtin_bit_cast(unsigned, b); }
__device__ __forceinline__ float bf_lo(unsigned u) { return __uint_as_float(u << 16); }
__device__ __forceinline__ float bf_hi(unsigned u) { return __uint_as_float(u & 0xffff0000u); }
__device__ __forceinline__ float silu_f(float g) { return g * __builtin_amdgcn_rcpf(1.0f + __expf(-g)); }

__device__ __forceinline__ float row_ss(const float* ssp, int row) {
    const f32x4 a = *(const f32x4*)(ssp + (size_t)row * 16), b = *(const f32x4*)(ssp + (size_t)row * 16 + 4), c = *(const f32x4*)(ssp + (size_t)row * 16 + 8), d = *(const f32x4*)(ssp + (size_t)row * 16 + 12);
    return ((a[0] + a[1]) + (a[2] + a[3])) + ((b[0] + b[1]) + (b[2] + b[3])) + ((c[0] + c[1]) + (c[2] + c[3])) + ((d[0] + d[1]) + (d[2] + d[3]));
}

__device__ __forceinline__ const LAS float* panel_scales(LAS unsigned char* xl, const float* ss, int pm) {
    LAS float* RSL = (LAS float*)xl; LAS int* tag = (LAS int*)(xl + 1024);
    if (*tag != pm) {
        const int tid = threadIdx.x;
        if (tid < 256) RSL[tid] = rsqrtf(row_ss(ss, pm * 256 + tid) * (1.0f / DM) + EPS);
        asm volatile("s_waitcnt lgkmcnt(0)" ::: "memory"); __builtin_amdgcn_s_barrier(); asm volatile("" ::: "memory");
        if (tid == 0) *tag = pm;
        asm volatile("s_waitcnt lgkmcnt(0)" ::: "memory"); __builtin_amdgcn_s_barrier(); asm volatile("" ::: "memory");
    }
    return RSL;
}

namespace pg8 {
constexpr int BM = 256, BK = 64, HALF = 128, HTB = HALF * BK * 2, STAGE_BYTES = 8 * HTB, NXCD = 8, WGM = 8;
__host__ __device__ __forceinline__ int lds_byte(int r, int c) { const int st = (r >> 4) * 2 + (c >> 5), rr = r & 15, cc = c & 31, ob = rr * 64 + cc * 2; return st * 1024 + (ob ^ (((ob >> 9) & 1) << 5)); }
__host__ __device__ __forceinline__ void stage_rc(int b, int& R, int& C) { const int st = b / 1024, sb = b % 1024, swz = sb ^ (((sb >> 9) & 1) << 5); R = (st >> 1) * 16 + swz / 64; C = (st & 1) * 32 + (swz % 64) / 2; }
__host__ __device__ __forceinline__ int perm32(int rho) { const int n = rho >> 4, i = rho & 15; return 8 * (i >> 2) + 4 * n + (i & 3); }
struct Unit { int pm, pn; };
struct Gemm { const bf16_t* A; const bf16_t* Bt; int M, N, K; };
struct StaticOrder {
    int nM, nN, nwg, G, c;
    __host__ __device__ void init(int M, int N, int G_, int c_) { nM = M / BM; nN = N / BM; nwg = nM * nN; G = G_; c = c_; }
    __host__ __device__ bool next(int i, Unit& u) const {
        const long L = (long)i * G + c; if (L >= nwg) return false;
        int wgid = (int)L; { const int q = nwg / NXCD, r = nwg % NXCD, xcd = wgid % NXCD, off = wgid / NXCD; wgid = (xcd < r ? xcd * (q + 1) : r * (q + 1) + (xcd - r) * q) + off; }
        const int nig = WGM * nN, gid = wgid / nig, fm = gid * WGM, gsz = (nM - fm) < WGM ? (nM - fm) : WGM;
        u.pm = fm + ((wgid % nig) % gsz); u.pn = (wgid % nig) / gsz; return true;
    }
    __device__ __forceinline__ void a_ready(const Unit&) const {}
    __device__ __forceinline__ void done(const Unit&) const {}
};

template <class Epi, class Sched, bool ALIGN_EPI = false, bool SP2 = false>
__device__ __forceinline__ void gemm_phase(LAS unsigned char* lds, const Gemm g, const Sched& S, const Epi& E) {
    const int tid = threadIdx.x, wid = __builtin_amdgcn_readfirstlane(tid >> 6), lane = tid & 63, wr = wid >> 2, wc = wid & 3, fr = lane & 15, fq = lane >> 4;
    const int K = g.K, nt = K / BK;
    unsigned voffA[2], voffB[2];
#pragma unroll
    for (int i = 0; i < 2; ++i) { int R, C; stage_rc(tid * 16 + i * 8192, R, C); const int Rb = Epi::PERM ? ((R & ~31) + perm32(R & 31)) : R;
        voffA[i] = (unsigned)(R * K + C) * 2u; voffB[i] = (unsigned)(Rb * K + C) * 2u; }
    const size_t kstep = (size_t)(BK * 2);
    const size_t hstep = (size_t)HALF * K * 2;
    const size_t tstep = 2 * hstep;
    const unsigned ldsw = (unsigned)wid * 1024u;
    const int aoff = lds_byte(wr * 64 + fr, fq * 8), boff = lds_byte(wc * 32 + fr, fq * 8);
#define PG8_SA(b, h) (((b) * 2 + (h)) * HTB)
#define PG8_SB(b, h) ((4 + (b) * 2 + (h)) * HTB)
#define PG8_STAGE(bufoff, gbase, voff) do { _Pragma("unroll") for (int _i = 0; _i < 2; ++_i) \
        __builtin_amdgcn_global_load_lds((const unsigned*)((const char*)(gbase) + (voff)[_i]), (LAS unsigned*)(lds + (bufoff) + ldsw + _i * 8192), 16, 0, 0); } while (0)
#define PG8_LDA(dst, b, h) do { _Pragma("unroll") for (int m = 0; m < 4; ++m) _Pragma("unroll") for (int k = 0; k < 2; ++k) dst[m][k] = *(const LAS bf16x8*)(lds + PG8_SA(b, h) + aoff + m * 2048 + k * 1024); } while (0)
#define PG8_LDB(dst, b, h) do { _Pragma("unroll") for (int n = 0; n < 2; ++n) _Pragma("unroll") for (int k = 0; k < 2; ++k) dst[n][k] = *(const LAS bf16x8*)(lds + PG8_SB(b, h) + boff + n * 2048 + k * 1024); } while (0)
#define PG8_MMA(ai, bj, At, Bt) do { __builtin_amdgcn_s_setprio(1); _Pragma("unroll") for (int m = 0; m < 4; ++m) _Pragma("unroll") for (int n = 0; n < 2; ++n) _Pragma("unroll") for (int k = 0; k < 2; ++k) \
        acc[ai][bj][m][n] = __builtin_amdgcn_mfma_f32_16x16x32_bf16(Bt[n][k], At[m][k], acc[ai][bj][m][n], 0, 0, 0); __builtin_amdgcn_s_setprio(0); } while (0)
#define PG8_WAIT_V(n) asm volatile("s_waitcnt vmcnt(" #n ")" ::: "memory")
#define PG8_WAIT_L(n) asm volatile("s_waitcnt lgkmcnt(" #n ")" ::: "memory")
#define PG8_BAR __builtin_amdgcn_s_barrier()
#define PG8_SCHED __builtin_amdgcn_sched_barrier(0)
    Unit cur, nxt; int ui = 0;
    if (!S.next(0, cur)) return;
    if constexpr (Epi::STAGGER) { const int slot = (blockIdx.x >> 3) & 7; for (int i = 0; i < slot; ++i) __builtin_amdgcn_s_sleep(32); }
    f32x4 acc[2][2][4][2];
#pragma unroll
    for (int a = 0; a < 2; ++a)
#pragma unroll
        for (int b = 0; b < 2; ++b)
#pragma unroll
            for (int m = 0; m < 4; ++m)
#pragma unroll
                for (int n = 0; n < 2; ++n) acc[a][b][m][n] = (f32x4){0.f, 0.f, 0.f, 0.f};
    bf16x8 At[4][2], B0[2][2], B1[2][2];
    const char* cA = (const char*)g.A + (size_t)cur.pm * tstep; const char* cB = (const char*)g.Bt + (size_t)cur.pn * tstep;
    S.a_ready(cur);
    if constexpr (SP2) {
        PG8_STAGE(PG8_SB(0, 0), cB, voffB); PG8_STAGE(PG8_SB(0, 1), cB + hstep, voffB); PG8_STAGE(PG8_SA(0, 0), cA, voffA); PG8_STAGE(PG8_SA(0, 1), cA + hstep, voffA);
        if (wr == 1) PG8_BAR;
        PG8_WAIT_V(2); PG8_BAR;
        PG8_STAGE(PG8_SB(1, 0), cB + kstep, voffB); PG8_STAGE(PG8_SA(1, 0), cA + kstep, voffA); PG8_STAGE(PG8_SB(1, 1), cB + hstep + kstep, voffB);
        PG8_WAIT_V(6); PG8_BAR;
    } else {
        PG8_STAGE(PG8_SB(0, 0), cB, voffB); PG8_STAGE(PG8_SA(0, 0), cA, voffA); PG8_STAGE(PG8_SB(0, 1), cB + hstep, voffB); PG8_STAGE(PG8_SA(0, 1), cA + hstep, voffA);
        if (wr == 1) PG8_BAR;
        PG8_WAIT_V(4); PG8_BAR;
        PG8_STAGE(PG8_SB(1, 0), cB + kstep, voffB); PG8_STAGE(PG8_SA(1, 0), cA + kstep, voffA); PG8_STAGE(PG8_SB(1, 1), cB + hstep + kstep, voffB);
        PG8_WAIT_V(6); PG8_BAR;
    }
    for (;;) {
        const bool has_next = S.next(ui + 1, nxt);
        const char* nA = has_next ? (const char*)g.A + (size_t)nxt.pm * tstep : cA; const char* nB = has_next ? (const char*)g.Bt + (size_t)nxt.pn * tstep : cB;
        for (int t = 0; t < nt; t += 2) {
            const bool last = (t == nt - 2);
            const char* a1 = cA + (size_t)(t + 1) * kstep;
            const char* a2 = last ? nA : cA + (size_t)(t + 2) * kstep; const char* b2 = last ? nB : cB + (size_t)(t + 2) * kstep;
            const char* a3 = a2 + kstep; const char* b3 = b2 + kstep;
            if (last && has_next) S.a_ready(nxt);
            if constexpr (SP2) {
            PG8_LDB(B0, 0, 0); PG8_LDB(B1, 0, 1); PG8_SCHED; PG8_LDA(At, 0, 0); PG8_STAGE(PG8_SA(1, 1), a1 + hstep, voffA);
            PG8_WAIT_V(8); PG8_WAIT_L(0); PG8_BAR; PG8_MMA(0, 0, At, B0); PG8_MMA(0, 1, At, B1); PG8_BAR; PG8_SCHED;
            PG8_LDA(At, 0, 1); PG8_STAGE(PG8_SB(0, 0), b2, voffB); PG8_STAGE(PG8_SB(0, 1), b2 + hstep, voffB); PG8_STAGE(PG8_SA(0, 0), a2, voffA);
            PG8_WAIT_V(8); PG8_WAIT_L(0); PG8_BAR; PG8_MMA(1, 0, At, B0); PG8_MMA(1, 1, At, B1); PG8_BAR; PG8_SCHED;
            PG8_LDB(B0, 1, 0); PG8_LDB(B1, 1, 1); PG8_SCHED; PG8_LDA(At, 1, 0); PG8_STAGE(PG8_SA(0, 1), a2 + hstep, voffA);
            PG8_WAIT_V(8); PG8_WAIT_L(0); PG8_BAR; PG8_MMA(0, 0, At, B0); PG8_MMA(0, 1, At, B1); PG8_BAR; PG8_SCHED;
            PG8_LDA(At, 1, 1); PG8_STAGE(PG8_SB(1, 0), b3, voffB); PG8_STAGE(PG8_SB(1, 1), b3 + hstep, voffB); PG8_STAGE(PG8_SA(1, 0), a3, voffA);
            PG8_WAIT_V(8); PG8_WAIT_L(0); PG8_BAR; PG8_MMA(1, 0, At, B0); PG8_MMA(1, 1, At, B1); PG8_BAR; PG8_SCHED;
            } else {
            PG8_LDB(B0, 0, 0); PG8_SCHED; PG8_LDA(At, 0, 0); PG8_STAGE(PG8_SA(1, 1), a1 + hstep, voffA);
            PG8_WAIT_L(8); PG8_BAR; PG8_WAIT_L(0); PG8_MMA(0, 0, At, B0); PG8_BAR; PG8_SCHED;
            PG8_LDB(B1, 0, 1); PG8_STAGE(PG8_SB(0, 0), b2, voffB);
            PG8_BAR; PG8_WAIT_L(0); PG8_MMA(0, 1, At, B1); PG8_BAR;
            PG8_LDA(At, 0, 1); PG8_STAGE(PG8_SA(0, 0), a2, voffA);
            PG8_BAR; PG8_WAIT_L(0); PG8_MMA(1, 0, At, B0); PG8_BAR; PG8_SCHED;
            PG8_STAGE(PG8_SB(0, 1), b2 + hstep, voffB);
            PG8_WAIT_V(6); PG8_BAR; PG8_MMA(1, 1, At, B1); PG8_BAR;
            PG8_LDB(B0, 1, 0); PG8_SCHED; PG8_LDA(At, 1, 0); PG8_STAGE(PG8_SA(0, 1), a2 + hstep, voffA);
            PG8_WAIT_L(8); PG8_BAR; PG8_WAIT_L(0); PG8_MMA(0, 0, At, B0); PG8_BAR; PG8_SCHED;
            PG8_LDB(B1, 1, 1); PG8_STAGE(PG8_SB(1, 0), b3, voffB);
            PG8_BAR; PG8_WAIT_L(0); PG8_MMA(0, 1, At, B1); PG8_BAR;
            PG8_LDA(At, 1, 1); PG8_STAGE(PG8_SA(1, 0), a3, voffA);
            PG8_BAR; PG8_WAIT_L(0); PG8_MMA(1, 0, At, B0); PG8_BAR; PG8_SCHED;
            PG8_STAGE(PG8_SB(1, 1), b3 + hstep, voffB);
            PG8_WAIT_V(6); PG8_BAR; PG8_MMA(1, 1, At, B1); PG8_BAR;
            }
        }
        if constexpr (ALIGN_EPI) { if (wr == 0) PG8_BAR; }
        E(acc, cur, wr, wc, fr, fq);
        if (!has_next) break;
#pragma unroll
        for (int a = 0; a < 2; ++a)
#pragma unroll
            for (int b = 0; b < 2; ++b)
#pragma unroll
                for (int m = 0; m < 4; ++m)
#pragma unroll
                    for (int n = 0; n < 2; ++n) acc[a][b][m][n] = (f32x4){0.f, 0.f, 0.f, 0.f};
        cur = nxt; cA = nA; cB = nB; ++ui;
        if constexpr (ALIGN_EPI) { if (wr == 1) PG8_BAR; }
    }
    PG8_WAIT_V(0);
    if constexpr (!ALIGN_EPI) { if (wr == 0) PG8_BAR; }
    PG8_BAR;
#undef PG8_SA
#undef PG8_SB
#undef PG8_STAGE
#undef PG8_LDA
#undef PG8_LDB
#undef PG8_MMA
#undef PG8_WAIT_V
#undef PG8_WAIT_L
#undef PG8_BAR
#undef PG8_SCHED
}

struct EpiSwiglu {
    static constexpr bool PERM = true, STAGGER = false;
    bf16_t* H; const float* ss; LAS unsigned char* xl;
    __device__ __forceinline__ void operator()(const f32x4 (&acc)[2][2][4][2], const Unit& u, int wr, int wc, int fr, int fq) const {
        const int row0 = u.pm * BM + wr * 64 + fr, col0 = u.pn * 128 + wc * 32 + 8 * fq;
        const LAS float* RSL = panel_scales(xl, ss, u.pm);
#pragma unroll
        for (int ai = 0; ai < 2; ++ai)
#pragma unroll
            for (int m = 0; m < 4; ++m) {
                const int row = row0 + ai * HALF + m * 16;
                const float rs = RSL[wr * 64 + fr + ai * HALF + m * 16];
                const float c1 = rs * -1.44269504089f, rs2 = rs * rs;
                f32x2_t hv[4];
#pragma unroll
                for (int n = 0; n < 2; ++n)
#pragma unroll
                    for (int q = 0; q < 2; ++q) {
                        const f32x2_t g2 = {acc[ai][0][m][n][2 * q], acc[ai][0][m][n][2 * q + 1]}, u2 = {acc[ai][1][m][n][2 * q], acc[ai][1][m][n][2 * q + 1]};
                        const f32x2_t a = g2 * c1; f32x2_t e; e.x = __builtin_amdgcn_exp2f(a.x); e.y = __builtin_amdgcn_exp2f(a.y);
                        const f32x2_t d = e + 1.0f; f32x2_t r; r.x = __builtin_amdgcn_rcpf(d.x); r.y = __builtin_amdgcn_rcpf(d.y);
                        hv[n * 2 + q] = (g2 * u2) * (r * rs2);
                    }
                u32x4 w; w.x = cvt_pk_bf16(hv[0].x, hv[0].y); w.y = cvt_pk_bf16(hv[1].x, hv[1].y); w.z = cvt_pk_bf16(hv[2].x, hv[2].y); w.w = cvt_pk_bf16(hv[3].x, hv[3].y);
                *(u32x4*)(H + (size_t)row * DFF + col0) = w;
            }
    }
};
template <bool BASE_F32> struct EpiResid {
    static constexpr bool PERM = true, STAGGER = false;
    const float* base_lo; const float* base_hi;
    bf16_t* xb; float* ss_out; float alpha;
    __device__ __forceinline__ void operator()(const f32x4 (&acc)[2][2][4][2], const Unit& u, int wr, int wc, int fr, int fq) const {
        const int row0 = u.pm * BM + wr * 64 + fr, col0 = u.pn * BM + wc * 32 + 8 * fq;
#pragma unroll
        for (int ai = 0; ai < 2; ++ai) {
            f32x4 bf[BASE_F32 ? 4 : 1][2][2]; u32x4 bh[BASE_F32 ? 1 : 4][2];
#pragma unroll
            for (int m = 0; m < 4; ++m) {
                const int row = row0 + ai * HALF + m * 16;
                if (BASE_F32) {
                    const float* bp = (row < T_PROMPT ? base_lo + (size_t)row * DM : base_hi + (size_t)(row - T_PROMPT) * DM) + col0;
#pragma unroll
                    for (int bj = 0; bj < 2; ++bj)
#pragma unroll
                        for (int n = 0; n < 2; ++n) bf[BASE_F32 ? m : 0][bj][n] = *(const f32x4*)(bp + bj * HALF + n * 4);
                } else {
                    const bf16_t* xp = xb + (size_t)row * DM + col0;
#pragma unroll
                    for (int bj = 0; bj < 2; ++bj) bh[BASE_F32 ? 0 : m][bj] = *(const u32x4*)(xp + bj * HALF);
                }
            }
            asm volatile("" ::: "memory");
#pragma unroll
            for (int m = 0; m < 4; ++m) {
                const int row = row0 + ai * HALF + m * 16;
                bf16_t* xp = xb + (size_t)row * DM + col0;
                float sq = 0.f;
#pragma unroll
                for (int bj = 0; bj < 2; ++bj) {
                    f32x4 b0, b1;
                    if (BASE_F32) { b0 = bf[BASE_F32 ? m : 0][bj][0]; b1 = bf[BASE_F32 ? m : 0][bj][1]; }
                    else { const u32x4 v = bh[BASE_F32 ? 0 : m][bj]; b0 = (f32x4){bf_lo(v.x), bf_hi(v.x), bf_lo(v.y), bf_hi(v.y)}; b1 = (f32x4){bf_lo(v.z), bf_hi(v.z), bf_lo(v.w), bf_hi(v.w)}; }
                    const f32x4 o0 = b0 + acc[ai][bj][m][0] * alpha, o1 = b1 + acc[ai][bj][m][1] * alpha;
                    u32x4 w; w.x = cvt_pk_bf16(o0[0], o0[1]); w.y = cvt_pk_bf16(o0[2], o0[3]); w.z = cvt_pk_bf16(o1[0], o1[1]); w.w = cvt_pk_bf16(o1[2], o1[3]);
                    *(u32x4*)(xp + bj * HALF) = w;
                    sq += ((o0[0] * o0[0] + o0[1] * o0[1]) + (o0[2] * o0[2] + o0[3] * o0[3])) + ((o1[0] * o1[0] + o1[1] * o1[1]) + (o1[2] * o1[2] + o1[3] * o1[3]));
                }
                sq += __shfl_xor(sq, 16); sq += __shfl_xor(sq, 32);
                if (fq == 0) ss_out[(size_t)row * 16 + u.pn * 4 + wc] = sq;
            }
        }
    }
};
struct EpiFinal {
    static constexpr bool PERM = true, STAGGER = false;
    const bf16_t* xb; float* out; const float* gain; float* xslot; unsigned* cnt; float alpha; LAS unsigned char* xl;
    __device__ __forceinline__ void operator()(f32x4 (&acc)[2][2][4][2], const Unit& u, int wr, int wc, int fr, int fq) const {
        LAS float* PL = (LAS float*)xl;
        LAS float* SL = (LAS float*)(xl + 4096);
        const int tid = threadIdx.x, lane = tid & 63, wid = __builtin_amdgcn_readfirstlane(tid >> 6);
        const int row0 = u.pm * BM + wr * 64 + fr, col0 = u.pn * BM + wc * 32 + 8 * fq;
#pragma unroll
        for (int ai = 0; ai < 2; ++ai)
#pragma unroll
            for (int m = 0; m < 4; ++m) {
                const int row = row0 + ai * HALF + m * 16;
                const bf16_t* xp = xb + (size_t)row * DM + col0;
                float sq = 0.f;
#pragma unroll
                for (int bj = 0; bj < 2; ++bj) {
                    const u32x4 v = *(const u32x4*)(xp + bj * HALF);
                    const f32x4 o0 = (f32x4){bf_lo(v.x), bf_hi(v.x), bf_lo(v.y), bf_hi(v.y)} + acc[ai][bj][m][0] * alpha;
                    const f32x4 o1 = (f32x4){bf_lo(v.z), bf_hi(v.z), bf_lo(v.w), bf_hi(v.w)} + acc[ai][bj][m][1] * alpha;
                    acc[ai][bj][m][0] = o0; acc[ai][bj][m][1] = o1;
                    sq += ((o0[0] * o0[0] + o0[1] * o0[1]) + (o0[2] * o0[2] + o0[3] * o0[3])) + ((o1[0] * o1[0] + o1[1] * o1[1]) + (o1[2] * o1[2] + o1[3] * o1[3]));
                }
                sq += __shfl_xor(sq, 16); sq += __shfl_xor(sq, 32);
                if (fq == 0) PL[(ai * HALF + wr * 64 + m * 16 + fr) * 4 + wc] = sq;
            }
        asm volatile("s_waitcnt lgkmcnt(0)" ::: "memory"); __builtin_amdgcn_s_barrier(); asm volatile("" ::: "memory");
        if (tid < 256) {
            const f32x4 v = *(const LAS f32x4*)(PL + tid * 4);
            __hip_atomic_store(xslot + (size_t)(u.pm * BM + tid) * 16 + u.pn, (v[0] + v[1]) + (v[2] + v[3]), __ATOMIC_RELAXED, __HIP_MEMORY_SCOPE_AGENT);
        }
        asm volatile("s_waitcnt vmcnt(0)" ::: "memory");
        if (wid < 4 && lane == 0) __hip_atomic_fetch_add(cnt + u.pm, 1u, __ATOMIC_RELAXED, __HIP_MEMORY_SCOPE_AGENT);
        if (wid == 0) {
            unsigned sp = 0;
            while ((unsigned)__builtin_amdgcn_readfirstlane(__hip_atomic_load(cnt + u.pm, __ATOMIC_RELAXED, __HIP_MEMORY_SCOPE_AGENT)) < 16u) { __builtin_amdgcn_s_sleep(2); if (++sp > (1u << 20)) break; }
            __builtin_amdgcn_fence(__ATOMIC_ACQUIRE, "agent");
            asm volatile("s_waitcnt vmcnt(0)" ::: "memory");
        }
        asm volatile("s_waitcnt vmcnt(0) lgkmcnt(0)" ::: "memory"); __builtin_amdgcn_s_barrier(); asm volatile("" ::: "memory");
        if (tid < 256) {
            const float* sl = xslot + (size_t)(u.pm * BM + tid) * 16;
            const float t = (__hip_atomic_load(sl + 0, __ATOMIC_RELAXED, __HIP_MEMORY_SCOPE_AGENT) + __hip_atomic_load(sl + 1, __ATOMIC_RELAXED, __HIP_MEMORY_SCOPE_AGENT))
                          + (__hip_atomic_load(sl + 2, __ATOMIC_RELAXED, __HIP_MEMORY_SCOPE_AGENT) + __hip_atomic_load(sl + 3, __ATOMIC_RELAXED, __HIP_MEMORY_SCOPE_AGENT));
            SL[tid] = rsqrtf(t * (1.0f / DM) + EPS);
        }
        asm volatile("s_waitcnt lgkmcnt(0)" ::: "memory"); __builtin_amdgcn_s_barrier(); asm volatile("" ::: "memory");
        f32x4 gv[2][2];
#pragma unroll
        for (int bj = 0; bj < 2; ++bj)
#pragma unroll
            for (int n = 0; n < 2; ++n) gv[bj][n] = *(const f32x4*)(gain + col0 + bj * HALF + n * 4);
#pragma unroll
        for (int ai = 0; ai < 2; ++ai)
#pragma unroll
            for (int m = 0; m < 4; ++m) {
                const int r = ai * HALF + wr * 64 + m * 16 + fr;
                const float rs = SL[r];
                float* op = out + (size_t)(u.pm * BM + r) * DM + col0;
#pragma unroll
                for (int bj = 0; bj < 2; ++bj)
#pragma unroll
                    for (int n = 0; n < 2; ++n) *(f32x4*)(op + bj * HALF + n * 4) = acc[ai][bj][m][n] * rs * gv[bj][n];
            }
    }
};
struct EpiIn {
    static constexpr bool PERM = true, STAGGER = false;
    bf16_t* P; float* R; const float* ss; LAS unsigned char* xl;
    __device__ __forceinline__ void operator()(const f32x4 (&acc)[2][2][4][2], const Unit& u, int wr, int wc, int fr, int fq) const {
        const int row0 = u.pm * BM + wr * 64 + fr; const int pn = u.pn;
        const LAS float* RSL = panel_scales(xl, ss, u.pm);
#pragma unroll
        for (int ai = 0; ai < 2; ++ai)
#pragma unroll
            for (int m = 0; m < 4; ++m) {
                const int row = row0 + ai * HALF + m * 16;
                const float rs = RSL[wr * 64 + fr + ai * HALF + m * 16];
                if (pn < 6 || pn == 10 || pn == 11) {
                    const float sc = (pn == 0) ? rs * 0.125f : rs;
                    const int cbase = (pn < 6 ? pn * 256 : PB + (pn - 10) * 256) + wc * 32 + 8 * fq;
#pragma unroll
                    for (int bj = 0; bj < 2; ++bj) {
                        const f32x4 v0 = acc[ai][bj][m][0] * sc, v1 = acc[ai][bj][m][1] * sc;
                        u32x4 w; w.x = cvt_pk_bf16(v0[0], v0[1]); w.y = cvt_pk_bf16(v0[2], v0[3]); w.z = cvt_pk_bf16(v1[0], v1[1]); w.w = cvt_pk_bf16(v1[2], v1[3]);
                        *(u32x4*)(P + (size_t)row * PLD + cbase + bj * HALF) = w;
                    }
                } else if (pn < 10) {
                    const float s2 = rs * rs;
                    const f32x4 v0 = acc[ai][0][m][0] * acc[ai][1][m][0] * s2, v1 = acc[ai][0][m][1] * acc[ai][1][m][1] * s2;
                    u32x4 w; w.x = cvt_pk_bf16(v0[0], v0[1]); w.y = cvt_pk_bf16(v0[2], v0[3]); w.z = cvt_pk_bf16(v1[0], v1[1]); w.w = cvt_pk_bf16(v1[2], v1[3]);
                    *(u32x4*)(P + (size_t)row * PLD + PZ + (pn - 6) * 128 + wc * 32 + 8 * fq) = w;
                } else {
                    if (wc == 0) {
                        *(f32x4*)(R + (size_t)row * 32 + 8 * fq) = acc[ai][0][m][0] * rs;
                        *(f32x4*)(R + (size_t)row * 32 + 8 * fq + 4) = acc[ai][0][m][1] * rs;
                    }
                }
            }
    }
};
}

__device__ __forceinline__ void transpose_item(const float* W, int N, int src_col0, const float* gain, bf16_t* WT, int K, int dst_row0, int k0, LAS float* scr, int lane) {
    const int c = lane & 7;
    if (src_col0 < 0) {
#pragma unroll
        for (int j = 0; j < 4; ++j) { const int n = (lane >> 3) + 8 * j; *(u32x4*)(WT + (size_t)(dst_row0 + n) * K + k0 + 8 * c) = (u32x4){0u, 0u, 0u, 0u}; }
        return;
    }
#pragma unroll 16
    for (int i = 0; i < 32; ++i) { const int kk = 2 * i + (lane >> 5); const float gm = gain ? gain[k0 + kk] : 1.0f; scr[kk * 33 + (lane & 31)] = W[(size_t)(k0 + kk) * N + src_col0 + (lane & 31)] * gm; }
    asm volatile("s_waitcnt lgkmcnt(0)" ::: "memory");
#pragma unroll
    for (int j = 0; j < 4; ++j) { const int n = (lane >> 3) + 8 * j; const LAS float* s = scr + (8 * c) * 33 + n;
        u32x4 o; o.x = cvt_pk_bf16(s[0 * 33], s[1 * 33]); o.y = cvt_pk_bf16(s[2 * 33], s[3 * 33]); o.z = cvt_pk_bf16(s[4 * 33], s[5 * 33]); o.w = cvt_pk_bf16(s[6 * 33], s[7 * 33]);
        *(u32x4*)(WT + (size_t)(dst_row0 + n) * K + k0 + 8 * c) = o; }
    asm volatile("s_waitcnt lgkmcnt(0)" ::: "memory");
}
__device__ __forceinline__ void transpose_matrix_item(int kind, const float* W, const float* W2, int Nsrc, const float* gain, bf16_t* WT, int K, int Ndst, int item, LAS float* scr, int lane) {
    const int nblk = Ndst / 32, kb = item / nblk, nb = item % nblk, n0 = nb * 32, k0 = kb * 64;
    const float* src = W; int col = n0;
    if (kind == 0) { const int tile = n0 >> 8, within = n0 & 255; if (within < 128) { col = tile * 128 + within; } else { src = W2; col = tile * 128 + within - 128; } }
    else if (kind == 2) {
        if (n0 < 1536) col = n0;
        else if (n0 < 2560) { const int tile = (n0 - 1536) >> 8, within = (n0 - 1536) & 255; col = (within < 128) ? 2080 + tile * 128 + within : 2592 + tile * 128 + within - 128; }
        else if (n0 < 3072) col = 1568 + (n0 - 2560);
        else if (n0 < 3104) col = 1536 + (n0 - 3072);
        else col = -1;
    }
    transpose_item(src, Nsrc, col, gain, WT, K, n0, k0, scr, lane);
}
__device__ __forceinline__ float wave_sum(float v) {
#pragma unroll
    for (int o = 1; o < 64; o <<= 1) v += __shfl_xor(v, o);
    return v;
}

__device__ __forceinline__ void p0_prologue(const Params& p, LAS unsigned char* lds) {
    const int tid = threadIdx.x, wave = tid >> 6, lane = tid & 63;
    LAS float* scr = (LAS float*)(lds + wave * 16384);
    const int gw = blockIdx.x * 8 + wave, NGW = gridDim.x * 8;
    unsigned char* ws = p.ws;
    constexpr int I_GU = (DM / 64) * (2 * DFF / 32), I_D = (DFF / 64) * (DM / 32), I_IN = (DM / 64) * (NIN_PAD / 32), I_O = (DM / 64) * (DM / 32);
    constexpr int NITEMS = 2 * I_GU + 2 * I_D + I_IN + I_O;
    for (int it = gw; it < NITEMS; it += NGW) {
        int r = it;
        if (r < I_GU) { transpose_matrix_item(0, p.ffn1_wg, p.ffn1_wu, DFF, p.ffn1_norm, (bf16_t*)(ws + WS_WGU1), DM, 2 * DFF, r, scr, lane); continue; } r -= I_GU;
        if (r < I_GU) { transpose_matrix_item(0, p.ffn2_wg, p.ffn2_wu, DFF, p.ffn2_norm, (bf16_t*)(ws + WS_WGU2), DM, 2 * DFF, r, scr, lane); continue; } r -= I_GU;
        if (r < I_D) { transpose_matrix_item(1, p.ffn1_wd, nullptr, DM, nullptr, (bf16_t*)(ws + WS_WD1), DFF, DM, r, scr, lane); continue; } r -= I_D;
        if (r < I_D) { transpose_matrix_item(1, p.ffn2_wd, nullptr, DM, nullptr, (bf16_t*)(ws + WS_WD2), DFF, DM, r, scr, lane); continue; } r -= I_D;
        if (r < I_IN) { transpose_matrix_item(2, p.w_in, nullptr, 3104, p.mix_norm, (bf16_t*)(ws + WS_WIN), DM, NIN_PAD, r, scr, lane); continue; } r -= I_IN;
        transpose_matrix_item(1, p.w_out, nullptr, DM, nullptr, (bf16_t*)(ws + WS_WOUT), DM, DM, r, scr, lane);
    }
    float* SS = (float*)(ws + WS_SS);
    bf16_t* XB = (bf16_t*)(ws + WS_XB);
    for (int rowb = gw * 4; rowb < T_TOK; rowb += NGW * 4) {
        f32x4 v[4][4];
#pragma unroll
        for (int r = 0; r < 4; ++r) { const int row = rowb + r;
            const float* xr = (row < T_PROMPT) ? p.x_prompt + (size_t)row * DM : p.x_sample + (size_t)(row - T_PROMPT) * DM;
#pragma unroll
            for (int j = 0; j < 4; ++j) v[r][j] = *(const f32x4*)(xr + j * 256 + lane * 4); }
#pragma unroll
        for (int r = 0; r < 4; ++r) { const int row = rowb + r; float s = 0.f;
#pragma unroll
            for (int j = 0; j < 4; ++j) {
                s += (v[r][j][0] * v[r][j][0] + v[r][j][1] * v[r][j][1]) + (v[r][j][2] * v[r][j][2] + v[r][j][3] * v[r][j][3]);
                u32x2 w; w.x = cvt_pk_bf16(v[r][j][0], v[r][j][1]); w.y = cvt_pk_bf16(v[r][j][2], v[r][j][3]);
                *(u32x2*)(XB + (size_t)row * DM + j * 256 + lane * 4) = w;
            }
            s = wave_sum(s);
            if (lane < 16) SS[(size_t)row * 16 + lane] = (lane == 0) ? s : 0.f; }
    }
}

template <int CTRL> __device__ __forceinline__ float dpp0(float v) { return __builtin_bit_cast(float, __builtin_amdgcn_update_dpp(0, __builtin_bit_cast(int, v), CTRL, 0xf, 0xf, true)); }
__device__ __forceinline__ float rdlane(float v, int l) { return __builtin_bit_cast(float, __builtin_amdgcn_readlane(__builtin_bit_cast(int, v), l)); }
template <int CTRL, int RMASK> __device__ __forceinline__ float dppm(float v) { return __builtin_bit_cast(float, __builtin_amdgcn_update_dpp(0, __builtin_bit_cast(int, v), CTRL, RMASK, 0xf, false)); }
template <int DIR> __device__ __forceinline__ float lane_scan(float x, int lane, float& tot) {
    float v = x;
    v += dpp0<0x111>(v); v += dpp0<0x112>(v); v += dpp0<0x114>(v); v += dpp0<0x118>(v);
    v += dppm<0x142, 0xa>(v);
    v += dppm<0x143, 0xc>(v);
    tot = rdlane(v, 63);
    return DIR == 0 ? v : (tot - v) + x;
}
__device__ __forceinline__ float log_sigmoid_f(float z) { return fminf(z, 0.f) - 0.69314718056f * __builtin_amdgcn_logf(1.0f + __expf(-fabsf(z))); }

#define LDS_BARRIER() do { asm volatile("s_waitcnt lgkmcnt(0)" ::: "memory"); __builtin_amdgcn_s_barrier(); asm volatile("" ::: "memory"); } while (0)
constexpr int LD72 = 72, LDV = 136, LDR = 36;
constexpr int L_GW = 0, L_GB = 32768, L_RAWQ = 34816, L_RAWK = L_RAWQ + 64 * LD72 * 2, L_RAWV = L_RAWK + 64 * LD72 * 2, L_RAWR = L_RAWV + 64 * LDV * 2,
              L_QD = L_RAWR + 64 * LDR * 4, L_KI = L_QD + 2 * 64 * LD72 * 2, L_VT = L_KI + 2 * 64 * LD72 * 2, L_PP = L_VT + 128 * LD72 * 2, L_SSQ = L_PP + 64 * LD72 * 2, L_GLA_END = L_SSQ + 2048;
static_assert(L_GLA_END <= 147456 - 64, "GLA LDS map");

struct GlaRaw { u32x4 q, k, v0, v1, r; };
template <bool NEED_Q> __device__ __forceinline__ void gla_raw_load(const Params& p, int chunk, int h, int tid, GlaRaw& g) {
    const int row = tid >> 3, c = tid & 7; const size_t tok = (size_t)chunk * 64 + row;
    const bf16_t* pr = (const bf16_t*)(p.ws + WS_P) + tok * PLD;
    if (NEED_Q) g.q = *(const u32x4*)(pr + PQ + h * 64 + c * 8);
    g.k = *(const u32x4*)(pr + PK + h * 64 + c * 8);
    g.v0 = *(const u32x4*)(pr + PV + h * 128 + c * 8); g.v1 = *(const u32x4*)(pr + PV + h * 128 + 64 + c * 8);
    g.r = *(const u32x4*)((const float*)(p.ws + WS_R) + tok * 32 + c * 4);
}
template <bool NEED_Q> __device__ __forceinline__ void gla_raw_store(LAS unsigned char* lds, int tid, const GlaRaw& g) {
    const int row = tid >> 3, c = tid & 7;
    if (NEED_Q) *(LAS u32x4*)(lds + L_RAWQ + (row * LD72 + c * 8) * 2) = g.q;
    *(LAS u32x4*)(lds + L_RAWK + (row * LD72 + c * 8) * 2) = g.k;
    *(LAS u32x4*)(lds + L_RAWV + (row * LDV + c * 8) * 2) = g.v0; *(LAS u32x4*)(lds + L_RAWV + (row * LDV + 64 + c * 8) * 2) = g.v1;
    *(LAS u32x4*)(lds + L_RAWR + (row * LDR + c * 4) * 4) = g.r;
}
__device__ __forceinline__ void gla_stage_gates(const Params& p, LAS unsigned char* lds, int tid) {
#pragma unroll
    for (int j = 0; j < 4; ++j) { const int i = tid + j * 512;
        const f32x4 v = (i < 1024) ? *(const f32x4*)(p.gfw + (size_t)i * 4) : *(const f32x4*)(p.gbw + (size_t)(i - 1024) * 4);
        *(LAS f32x4*)(lds + L_GW + i * 16) = v; }
    if (tid < 128) { const f32x4 v = (tid < 64) ? *(const f32x4*)(p.gfb + tid * 4) : *(const f32x4*)(p.gbb + (tid - 64) * 4); *(LAS f32x4*)(lds + L_GB + tid * 16) = v; }
}

template <int MODE, int DIR> __device__ __forceinline__ void gla_prep(const Params& p, LAS unsigned char* lds, int chunk, int h, int w, int lane) {
    constexpr int dir = DIR; const int dg = w & 3;
    LAS bf16_t* VT = (LAS bf16_t*)(lds + L_VT);
    float rr[16];
#pragma unroll
    for (int j = 0; j < 4; ++j) { const f32x4 v = *(const LAS f32x4*)(lds + L_RAWR + (lane * LDR + dir * 16 + j * 4) * 4); rr[j * 4 + 0] = v[0]; rr[j * 4 + 1] = v[1]; rr[j * 4 + 2] = v[2]; rr[j * 4 + 3] = v[3]; }
    const u32x4 k0 = *(const LAS u32x4*)(lds + L_RAWK + (lane * LD72 + dg * 16) * 2), k1 = *(const LAS u32x4*)(lds + L_RAWK + (lane * LD72 + dg * 16 + 8) * 2);
    const u32x4 v0 = *(const LAS u32x4*)(lds + L_RAWV + (lane * LDV + w * 16) * 2), v1 = *(const LAS u32x4*)(lds + L_RAWV + (lane * LDV + w * 16 + 8) * 2);
    u32x4 q0 = (u32x4){0u, 0u, 0u, 0u}, q1 = q0;
    if (MODE == 1) { q0 = *(const LAS u32x4*)(lds + L_RAWQ + (lane * LD72 + dg * 16) * 2); q1 = *(const LAS u32x4*)(lds + L_RAWQ + (lane * LD72 + dg * 16 + 8) * 2); }
    const unsigned qq[8] = {q0.x, q0.y, q0.z, q0.w, q1.x, q1.y, q1.z, q1.w};
    const unsigned kk[8] = {k0.x, k0.y, k0.z, k0.w, k1.x, k1.y, k1.z, k1.w};
    const unsigned vv[8] = {v0.x, v0.y, v0.z, v0.w, v1.x, v1.y, v1.z, v1.w};
#pragma unroll
    for (int e = 0; e < 8; ++e) { VT[(w * 16 + 2 * e) * LD72 + lane] = (bf16_t)(vv[e] & 0xffffu); VT[(w * 16 + 2 * e + 1) * LD72 + lane] = (bf16_t)(vv[e] >> 16); }
    typedef const __attribute__((address_space(4))) float cfloat; typedef const __attribute__((address_space(4))) f32x4 cf32x4;
    cfloat* gwl = (cfloat*)(DIR ? p.gbw : p.gfw) + h * 64 + dg * 16;
    cfloat* gbl = (cfloat*)(DIR ? p.gbb : p.gfb) + h * 64 + dg * 16;
    float qd[16], ki[16]; float decv = 0.f;
#pragma unroll
    for (int c4 = 0; c4 < 4; ++c4) {
        f32x4 zz = *(cf32x4*)(gbl + c4 * 4);
#pragma unroll
        for (int r = 0; r < 16; ++r) { const f32x4 g = *(cf32x4*)(gwl + r * 256 + c4 * 4); zz = zz + g * rr[r]; }
#pragma unroll
        for (int e = 0; e < 4; ++e) {
            const int cc = c4 * 4 + e;
            const float la = log_sigmoid_f(zz[e]) * (1.0f / 16.0f);
            float tot; const float cum = lane_scan<DIR>(la, lane, tot);
            const float kv = (cc & 1) ? bf_hi(kk[cc >> 1]) : bf_lo(kk[cc >> 1]);
            if (MODE == 0) {
                const float kt = kv * __expf(tot - cum);
                ((LAS bf16_t*)(lds + L_QD))[(dir * 64 + dg * 16 + cc) * LD72 + lane] = (bf16_t)(cvt_pk_bf16(kt, 0.f) & 0xffffu);
                decv = (lane == cc) ? tot : decv;
            } else {
                const float qv = (cc & 1) ? bf_hi(qq[cc >> 1]) : bf_lo(qq[cc >> 1]);
                qd[cc] = qv * __expf(cum); ki[cc] = kv * __expf(-cum);
            }
        }
    }
    if (MODE == 0) { if (lane < 16) ((float*)(p.ws + WS_DEC))[((size_t)(chunk * 4 + h) * 2 + dir) * 64 + dg * 16 + lane] = __expf(decv); }
    if (MODE == 1) {
        LAS bf16_t* QD = (LAS bf16_t*)(lds + L_QD); LAS bf16_t* KI = (LAS bf16_t*)(lds + L_KI);
        u32x4 a, b;
        a.x = cvt_pk_bf16(qd[0], qd[1]); a.y = cvt_pk_bf16(qd[2], qd[3]); a.z = cvt_pk_bf16(qd[4], qd[5]); a.w = cvt_pk_bf16(qd[6], qd[7]);
        b.x = cvt_pk_bf16(qd[8], qd[9]); b.y = cvt_pk_bf16(qd[10], qd[11]); b.z = cvt_pk_bf16(qd[12], qd[13]); b.w = cvt_pk_bf16(qd[14], qd[15]);
        *(LAS u32x4*)(QD + (dir * 64 + lane) * LD72 + dg * 16) = a; *(LAS u32x4*)(QD + (dir * 64 + lane) * LD72 + dg * 16 + 8) = b;
        a.x = cvt_pk_bf16(ki[0], ki[1]); a.y = cvt_pk_bf16(ki[2], ki[3]); a.z = cvt_pk_bf16(ki[4], ki[5]); a.w = cvt_pk_bf16(ki[6], ki[7]);
        b.x = cvt_pk_bf16(ki[8], ki[9]); b.y = cvt_pk_bf16(ki[10], ki[11]); b.z = cvt_pk_bf16(ki[12], ki[13]); b.w = cvt_pk_bf16(ki[14], ki[15]);
        *(LAS u32x4*)(KI + (dir * 64 + lane) * LD72 + dg * 16) = a; *(LAS u32x4*)(KI + (dir * 64 + lane) * LD72 + dg * 16 + 8) = b;
    }
}

struct ConvW { float w0[8], w1[8], w2[8], gn[8]; };
struct ConvRows { u32x4 zc[2], zm[2], zp[2], bb[2]; };
__device__ __forceinline__ void conv_weights(const Params& p, int tid, ConvW& W) {
    const int ch0 = (tid & 63) * 8;
#pragma unroll
    for (int j = 0; j < 2; ++j) {
        const f32x4 a = *(const f32x4*)(p.conv_w + ch0 + j * 4), b = *(const f32x4*)(p.conv_w + 512 + ch0 + j * 4), c = *(const f32x4*)(p.conv_w + 1024 + ch0 + j * 4), g = *(const f32x4*)(p.conv_norm + ch0 + j * 4);
#pragma unroll
        for (int e = 0; e < 4; ++e) { W.w0[j * 4 + e] = a[e]; W.w1[j * 4 + e] = b[e]; W.w2[j * 4 + e] = c[e]; W.gn[j * 4 + e] = g[e]; }
    }
}
__device__ __forceinline__ void conv_load2(const Params& p, int chunk, int k0, int tid, ConvRows& R) {
    const bf16_t* P = (const bf16_t*)(p.ws + WS_P);
    const int ch0 = (tid & 63) * 8;
#pragma unroll
    for (int k = 0; k < 2; ++k) {
        const int t = chunk * 64 + (tid >> 6) + 8 * (k0 + k);
        const bool first = (t == 0) || (t >= T_PROMPT && ((t - T_PROMPT) & (SAMPLE_LEN - 1)) == 0);
        const bool last = (t == T_PROMPT - 1) || (t >= T_PROMPT && ((t - T_PROMPT) & (SAMPLE_LEN - 1)) == SAMPLE_LEN - 1);
        const bf16_t* pr = P + (size_t)t * PLD;
        R.zc[k] = *(const u32x4*)(pr + PZ + ch0);
        R.zm[k] = first ? (u32x4){0u, 0u, 0u, 0u} : *(const u32x4*)(pr - PLD + PZ + ch0);
        R.zp[k] = last ? (u32x4){0u, 0u, 0u, 0u} : *(const u32x4*)(pr + PLD + PZ + ch0);
        R.bb[k] = *(const u32x4*)(pr + PB + ch0);
    }
}
__device__ __forceinline__ void conv_finish2(const Params& p, int chunk, int k0, int tid, const ConvRows& R, const ConvW& W) {
    bf16_t* MIX = (bf16_t*)(p.ws + WS_MIX);
    const int ch0 = (tid & 63) * 8;
#pragma unroll
    for (int k = 0; k < 2; ++k) {
        const int t = chunk * 64 + (tid >> 6) + 8 * (k0 + k);
        float y[8]; float sq = 0.f;
#pragma unroll
        for (int e = 0; e < 4; ++e) {
            const float c0 = bf_lo(R.zm[k][e]) * W.w0[2 * e] + bf_lo(R.zc[k][e]) * W.w1[2 * e] + bf_lo(R.zp[k][e]) * W.w2[2 * e];
            const float c1 = bf_hi(R.zm[k][e]) * W.w0[2 * e + 1] + bf_hi(R.zc[k][e]) * W.w1[2 * e + 1] + bf_hi(R.zp[k][e]) * W.w2[2 * e + 1];
            y[2 * e] = bf_lo(R.bb[k][e]) * c0; y[2 * e + 1] = bf_hi(R.bb[k][e]) * c1;
            sq += y[2 * e] * y[2 * e] + y[2 * e + 1] * y[2 * e + 1];
        }
        sq += __shfl_xor(sq, 1); sq += __shfl_xor(sq, 2); sq += __shfl_xor(sq, 4);
        const float rn = rsqrtf(sq * (1.0f / 64.0f) + EPS);
        u32x4 o;
        o.x = cvt_pk_bf16(y[0] * rn * W.gn[0], y[1] * rn * W.gn[1]); o.y = cvt_pk_bf16(y[2] * rn * W.gn[2], y[3] * rn * W.gn[3]);
        o.z = cvt_pk_bf16(y[4] * rn * W.gn[4], y[5] * rn * W.gn[5]); o.w = cvt_pk_bf16(y[6] * rn * W.gn[6], y[7] * rn * W.gn[7]);
        *(u32x4*)(MIX + (size_t)t * DM + 512 + ch0) = o;
    }
}

__device__ __forceinline__ void p4_gla_phase(const Params& p, LAS unsigned char* lds) {
    const int tid = threadIdx.x, w = __builtin_amdgcn_readfirstlane(tid >> 6), lane = tid & 63, dir = w >> 2, dg = w & 3, fr = lane & 15, fq = lane >> 4;
    const int G = gridDim.x, NIT = NCHUNK * 4;
    int it = blockIdx.x;
    ConvW CW; conv_weights(p, tid, CW);
    int cs = 0; const int ncs = (blockIdx.x < NCHUNK) ? 8 * ((NCHUNK - 1 - (int)blockIdx.x) / G + 1) : 0;
    if (it < NIT) {
    GlaRaw raw; gla_raw_load<false>(p, it >> 2, it & 3, tid, raw);
    LAS bf16_t* KT = (LAS bf16_t*)(lds + L_QD); LAS bf16_t* VT = (LAS bf16_t*)(lds + L_VT);
    bf16_t* ST = (bf16_t*)(p.ws + WS_ST);
    for (; it < NIT; it += G) {
        const int chunk = it >> 2, h = it & 3;
        gla_raw_store<false>(lds, tid, raw);
        LDS_BARRIER();
        if (it + G < NIT) gla_raw_load<false>(p, (it + G) >> 2, (it + G) & 3, tid, raw);
        const bool cv = cs < ncs; ConvRows CR;
        if (cv) conv_load2(p, (int)blockIdx.x + (cs >> 3) * G, cs & 7, tid, CR);
        if (w < 4) gla_prep<0, 0>(p, lds, chunk, h, w, lane); else gla_prep<0, 1>(p, lds, chunk, h, w, lane);
        LDS_BARRIER();
        f32x4 acc[4][2];
#pragma unroll
        for (int mt = 0; mt < 4; ++mt)
#pragma unroll
            for (int nn = 0; nn < 2; ++nn) acc[mt][nn] = (f32x4){0.f, 0.f, 0.f, 0.f};
#pragma unroll
        for (int ks = 0; ks < 2; ++ks) {
            bf16x8 a[4], b[2];
#pragma unroll
            for (int mt = 0; mt < 4; ++mt) a[mt] = *(const LAS bf16x8*)(KT + (dir * 64 + mt * 16 + fr) * LD72 + ks * 32 + fq * 8);
#pragma unroll
            for (int nn = 0; nn < 2; ++nn) b[nn] = *(const LAS bf16x8*)(VT + ((dg * 2 + nn) * 16 + fr) * LD72 + ks * 32 + fq * 8);
#pragma unroll
            for (int mt = 0; mt < 4; ++mt)
#pragma unroll
                for (int nn = 0; nn < 2; ++nn) acc[mt][nn] = __builtin_amdgcn_mfma_f32_16x16x32_bf16(a[mt], b[nn], acc[mt][nn], 0, 0, 0);
        }
        bf16_t* sb = ST + ((size_t)(chunk * 4 + h) * 2 + dir) * 8192;
#pragma unroll
        for (int mt = 0; mt < 4; ++mt)
#pragma unroll
            for (int nn = 0; nn < 2; ++nn) {
                const int dv = (dg * 2 + nn) * 16 + fr, dk0 = mt * 16 + 4 * fq;
                u32x2 o; o.x = cvt_pk_bf16(acc[mt][nn][0], acc[mt][nn][1]); o.y = cvt_pk_bf16(acc[mt][nn][2], acc[mt][nn][3]);
                *(u32x2*)(sb + dv * 64 + dk0) = o;
            }
        if (cv) { conv_finish2(p, (int)blockIdx.x + (cs >> 3) * G, cs & 7, tid, CR, CW); cs += 2; }
    }
    }
    for (; cs < ncs; cs += 2) { ConvRows CR; conv_load2(p, (int)blockIdx.x + (cs >> 3) * G, cs & 7, tid, CR); conv_finish2(p, (int)blockIdx.x + (cs >> 3) * G, cs & 7, tid, CR, CW); }
}

__device__ __forceinline__ void p6_gla_phase(const Params& p, LAS unsigned char* lds) {
    const int tid = threadIdx.x, w = __builtin_amdgcn_readfirstlane(tid >> 6), lane = tid & 63, fr = lane & 15, fq = lane >> 4;
    const int G = gridDim.x, NIT = NCHUNK * 4;
    int it = blockIdx.x; if (it >= NIT) return;
    GlaRaw raw; gla_raw_load<true>(p, it >> 2, it & 3, tid, raw);
    LAS bf16_t* QD = (LAS bf16_t*)(lds + L_QD); LAS bf16_t* KI = (LAS bf16_t*)(lds + L_KI); LAS bf16_t* VT = (LAS bf16_t*)(lds + L_VT); LAS bf16_t* PP = (LAS bf16_t*)(lds + L_PP);
    LAS float* SSQ = (LAS float*)(lds + L_SSQ);
    const bf16_t* P = (const bf16_t*)(p.ws + WS_P);
    const bf16_t* ST = (const bf16_t*)(p.ws + WS_ST);
    bf16_t* MIX = (bf16_t*)(p.ws + WS_MIX);
    const int ti = w & 3, hf = w >> 2;
    for (; it < NIT; it += G) {
        const int chunk = it >> 2, h = it & 3;
        gla_raw_store<true>(lds, tid, raw);
        LDS_BARRIER();
        if (it + G < NIT) gla_raw_load<true>(p, (it + G) >> 2, (it + G) & 3, tid, raw);
        bf16x8 sfr[2][2];
#pragma unroll
        for (int d2 = 0; d2 < 2; ++d2) { const bf16_t* sbase = ST + ((size_t)(chunk * 4 + h) * 2 + d2) * 8192;
#pragma unroll
            for (int ks = 0; ks < 2; ++ks) sfr[d2][ks] = *(const bf16x8*)(sbase + (w * 16 + fr) * 64 + ks * 32 + fq * 8); }
        const int i = ti * 16 + fr;
        const int vcol = h * 128 + w * 16 + 4 * fq;
        u32x2 gv[4];
#pragma unroll
        for (int x = 0; x < 4; ++x) gv[x] = *(const u32x2*)(P + ((size_t)chunk * 64 + x * 16 + fr) * PLD + PG + vcol);
        const f32x4 hn = *(const f32x4*)(p.gla_norm + vcol);
        if (w < 4) gla_prep<1, 0>(p, lds, chunk, h, w, lane); else gla_prep<1, 1>(p, lds, chunk, h, w, lane);
        LDS_BARRIER();
#pragma unroll
        for (int jj = 0; jj < 2; ++jj) {
            const int jt = hf * 2 + jj;
            f32x4 sf = (f32x4){0.f, 0.f, 0.f, 0.f}, sb = (f32x4){0.f, 0.f, 0.f, 0.f};
#pragma unroll
            for (int ks = 0; ks < 2; ++ks) {
                const bf16x8 af = *(const LAS bf16x8*)(KI + (0 * 64 + jt * 16 + fr) * LD72 + ks * 32 + fq * 8);
                const bf16x8 bfw = *(const LAS bf16x8*)(QD + (0 * 64 + ti * 16 + fr) * LD72 + ks * 32 + fq * 8);
                sf = __builtin_amdgcn_mfma_f32_16x16x32_bf16(af, bfw, sf, 0, 0, 0);
                const bf16x8 ab = *(const LAS bf16x8*)(KI + (1 * 64 + jt * 16 + fr) * LD72 + ks * 32 + fq * 8);
                const bf16x8 bb = *(const LAS bf16x8*)(QD + (1 * 64 + ti * 16 + fr) * LD72 + ks * 32 + fq * 8);
                sb = __builtin_amdgcn_mfma_f32_16x16x32_bf16(ab, bb, sb, 0, 0, 0);
            }
            float pv[4];
#pragma unroll
            for (int e = 0; e < 4; ++e) { const int j = jt * 16 + 4 * fq + e; pv[e] = (j <= i ? sf[e] : 0.f) + (j >= i ? sb[e] : 0.f); }
            u32x2 o; o.x = cvt_pk_bf16(pv[0], pv[1]); o.y = cvt_pk_bf16(pv[2], pv[3]);
            *(LAS u32x2*)(PP + i * LD72 + jt * 16 + 4 * fq) = o;
        }
        LDS_BARRIER();
        f32x4 acc[4];
#pragma unroll
        for (int x = 0; x < 4; ++x) acc[x] = (f32x4){0.f, 0.f, 0.f, 0.f};
#pragma unroll
        for (int ks = 0; ks < 2; ++ks) {
            const bf16x8 a = *(const LAS bf16x8*)(VT + (w * 16 + fr) * LD72 + ks * 32 + fq * 8);
#pragma unroll
            for (int x = 0; x < 4; ++x) {
                const bf16x8 b = *(const LAS bf16x8*)(PP + (x * 16 + fr) * LD72 + ks * 32 + fq * 8);
                acc[x] = __builtin_amdgcn_mfma_f32_16x16x32_bf16(a, b, acc[x], 0, 0, 0);
            }
        }
#pragma unroll
        for (int d2 = 0; d2 < 2; ++d2)
#pragma unroll
            for (int ks = 0; ks < 2; ++ks) {
#pragma unroll
                for (int x = 0; x < 4; ++x) {
                    const bf16x8 b = *(const LAS bf16x8*)(QD + (d2 * 64 + x * 16 + fr) * LD72 + ks * 32 + fq * 8);
                    acc[x] = __builtin_amdgcn_mfma_f32_16x16x32_bf16(sfr[d2][ks], b, acc[x], 0, 0, 0);
                }
            }
#pragma unroll
        for (int x = 0; x < 4; ++x) {
            float sq = (acc[x][0] * acc[x][0] + acc[x][1] * acc[x][1]) + (acc[x][2] * acc[x][2] + acc[x][3] * acc[x][3]);
            sq += __shfl_xor(sq, 16); sq += __shfl_xor(sq, 32);
            if (fq == 0) SSQ[w * 64 + x * 16 + fr] = sq;
        }
        LDS_BARRIER();
#pragma unroll
        for (int x = 0; x < 4; ++x) {
            const int tk = x * 16 + fr; float tot = 0.f;
#pragma unroll
            for (int ww = 0; ww < 8; ++ww) tot += SSQ[ww * 64 + tk];
            const float rn = rsqrtf(tot * (1.0f / 128.0f) + EPS);
            const float o0 = acc[x][0] * rn * hn[0] * silu_f(bf_lo(gv[x].x)), o1 = acc[x][1] * rn * hn[1] * silu_f(bf_hi(gv[x].x));
            const float o2 = acc[x][2] * rn * hn[2] * silu_f(bf_lo(gv[x].y)), o3 = acc[x][3] * rn * hn[3] * silu_f(bf_hi(gv[x].y));
            u32x2 o; o.x = cvt_pk_bf16(o0, o1); o.y = cvt_pk_bf16(o2, o3);
            *(u32x2*)(MIX + ((size_t)chunk * 64 + tk) * DM + vcol) = o;
        }
    }
}

template <int EPT, int UB> struct ScanBatch { u32x4 x8[EPT == 8 ? UB : 1]; f32x4 da[EPT == 8 ? UB : 1], db[EPT == 8 ? UB : 1]; bf16_t x1[EPT == 1 ? UB : 1]; float d1[EPT == 1 ? UB : 1]; };
template <int EPT, int UB> __device__ __forceinline__ void scan_load(ScanBatch<EPT, UB>& B, const bf16_t* sp, const float* dp, long cs, long ds, int n0) {
#pragma unroll
    for (int i = 0; i < UB; ++i) {
        if constexpr (EPT == 1) { B.x1[i] = sp[cs * (n0 + i)]; B.d1[i] = dp[ds * (n0 + i)]; }
        else { B.x8[i] = *(const u32x4*)(sp + cs * (n0 + i)); B.da[i] = *(const f32x4*)(dp + ds * (n0 + i)); B.db[i] = *(const f32x4*)(dp + ds * (n0 + i) + 4); }
    }
}
template <int EPT, int UB> __device__ __forceinline__ void scan_step(const ScanBatch<EPT, UB>& B, float (&S)[EPT], bf16_t* sp, long cs, int n0) {
#pragma unroll
    for (int i = 0; i < UB; ++i) {
        if constexpr (EPT == 1) { sp[cs * (n0 + i)] = (bf16_t)(cvt_pk_bf16(S[0], 0.f) & 0xffffu); S[0] = B.d1[i] * S[0] + __uint_as_float(((unsigned)B.x1[i]) << 16); }
        else {
            u32x4 o; o.x = cvt_pk_bf16(S[0], S[1]); o.y = cvt_pk_bf16(S[2], S[3]); o.z = cvt_pk_bf16(S[4], S[5]); o.w = cvt_pk_bf16(S[6], S[7]);
            *(u32x4*)(sp + cs * (n0 + i)) = o;
            S[0] = B.da[i][0] * S[0] + bf_lo(B.x8[i].x); S[1] = B.da[i][1] * S[1] + bf_hi(B.x8[i].x); S[2] = B.da[i][2] * S[2] + bf_lo(B.x8[i].y); S[3] = B.da[i][3] * S[3] + bf_hi(B.x8[i].y);
            S[4] = B.db[i][0] * S[4] + bf_lo(B.x8[i].z); S[5] = B.db[i][1] * S[5] + bf_hi(B.x8[i].z); S[6] = B.db[i][2] * S[6] + bf_lo(B.x8[i].w); S[7] = B.db[i][3] * S[7] + bf_hi(B.x8[i].w);
        }
    }
}
template <int EPT, int UB>
__device__ __forceinline__ void p5_scan(bf16_t* ST, const float* DEC, int head, int dir, int c_first, int nchunks, int e0) {
    const long sgn = dir ? -1 : 1; const long cs = sgn * (4 * 2 * 8192), ds = sgn * (4 * 2 * 64);
    const int c0 = dir ? c_first + nchunks - 1 : c_first;
    bf16_t* sp = ST + ((size_t)(c0 * 4 + head) * 2 + dir) * 8192 + e0;
    const float* dp = DEC + ((size_t)(c0 * 4 + head) * 2 + dir) * 64 + (e0 & 63);
    float S[EPT];
#pragma unroll
    for (int e = 0; e < EPT; ++e) S[e] = 0.f;
    ScanBatch<EPT, UB> A, B;
    scan_load<EPT, UB>(A, sp, dp, cs, ds, 0);
    for (int n0 = 0; n0 < nchunks; n0 += 2 * UB) {
        scan_load<EPT, UB>(B, sp, dp, cs, ds, n0 + UB);
        scan_step<EPT, UB>(A, S, sp, cs, n0);
        if (n0 + 2 * UB < nchunks) scan_load<EPT, UB>(A, sp, dp, cs, ds, n0 + 2 * UB);
        scan_step<EPT, UB>(B, S, sp, cs, n0 + UB);
    }
}

#define XB_TMO      128
#define XB_XCNT(j)  (256  + 64 * (j))
#define XB_XSUB(j)  (1280 + 64 * (j))
#define XB_XGEN(j)  (2304 + 64 * (j))
#define XB_TOP      3328
#define XB_TOPGEN   3392
#define XCD_BAR_WORDS 3456
#define XB_SPIN_CAP (1u << 18)
__device__ __forceinline__ unsigned xb_ld(unsigned* p)              { return __hip_atomic_load(p, __ATOMIC_RELAXED, __HIP_MEMORY_SCOPE_AGENT); }
__device__ __forceinline__ unsigned xb_add(unsigned* p, unsigned v) { return __hip_atomic_fetch_add(p, v, __ATOMIC_RELAXED, __HIP_MEMORY_SCOPE_AGENT); }
__device__ __forceinline__ unsigned xb_xcc_id() { return (unsigned)__builtin_amdgcn_s_getreg((3 << 11) | 20) & 0xFu; }
#define XB_SPIN(cond, bar) do { unsigned _sp = 0; while (cond) { __builtin_amdgcn_s_sleep(1); \
    if ((++_sp & 255u) == 0u) { if (xb_ld(&(bar)[XB_TMO])) break; if (_sp > XB_SPIN_CAP) { atomicAdd(&(bar)[XB_TMO], 1u); break; } } } } while (0)
struct XcdBarrier { unsigned* bar; unsigned x; volatile LAS unsigned* st; };
__device__ __forceinline__ XcdBarrier xcd_barrier_post(unsigned* bar, volatile LAS unsigned* st) {
    XcdBarrier b; b.bar = bar; b.x = xb_xcc_id(); b.st = st;
    if (threadIdx.x == 0) (void)xb_add(&bar[XB_XCNT(b.x)], 1u);
    return b;
}
__device__ __forceinline__ void xcd_barrier_complete(unsigned* bar, unsigned x, unsigned& nloc, unsigned& nx) {
    const unsigned G = gridDim.x * gridDim.y * gridDim.z;
    unsigned sum, cnt, mine, sp = 0u;
    for (;;) {
        sum = 0u; cnt = 0u; mine = 0u;
#pragma unroll
        for (unsigned j = 0; j < 16; ++j) { const unsigned c = xb_ld(&bar[XB_XCNT(j)]); sum += c; cnt += (c > 0u) ? 1u : 0u; mine = (j == x) ? c : mine; }
        if (sum == G) break;
        __builtin_amdgcn_s_sleep(1);
        if ((++sp & 255u) == 0u) { if (xb_ld(&bar[XB_TMO])) break; if (sp > XB_SPIN_CAP) { atomicAdd(&bar[XB_TMO], 1u); break; } }
    }
    nloc = mine > 0u ? mine : 1u; nx = cnt > 0u ? cnt : 1u;
}
__device__ __forceinline__ void xcd_barrier(const XcdBarrier& b) {
    asm volatile("s_waitcnt vmcnt(0)" ::: "memory");
    __syncthreads();
    if (threadIdx.x == 0) {
        unsigned* bar = b.bar;
        __builtin_amdgcn_s_waitcnt(0);
        unsigned nloc = b.st[0], nx = b.st[1];
        if (nloc == 0u) { xcd_barrier_complete(bar, b.x, nloc, nx); b.st[0] = nloc; b.st[1] = nx; }
        const unsigned old = xb_add(&bar[XB_XSUB(b.x)], 1u);
        const unsigned gen = old / nloc;
        if (old + 1u == (gen + 1u) * nloc) {
            __builtin_amdgcn_fence(__ATOMIC_RELEASE, "agent");
            asm volatile("s_waitcnt vmcnt(0)" ::: "memory");
            const unsigned og = xb_add(&bar[XB_TOP], 1u);
            const unsigned tg = og / nx;
            if (og + 1u == (tg + 1u) * nx) xb_add(&bar[XB_TOPGEN], 1u);
            else XB_SPIN(xb_ld(&bar[XB_TOPGEN]) == tg, bar);
            __builtin_amdgcn_fence(__ATOMIC_ACQUIRE, "agent");
            xb_add(&bar[XB_XGEN(b.x)], 1u);
            asm volatile("s_waitcnt vmcnt(0)" ::: "memory");
        } else {
            XB_SPIN(xb_ld(&bar[XB_XGEN(b.x)]) == gen, bar);
            __builtin_amdgcn_fence(__ATOMIC_ACQUIRE, "agent");
            asm volatile("s_waitcnt vmcnt(0)" ::: "memory");
        }
    }
    __syncthreads();
}

constexpr int LDS_BYTES = 147456;
__global__ void __launch_bounds__(512, 2) fwd_megakernel(Params p) {
    extern __shared__ __attribute__((aligned(16))) unsigned char lds_raw[];
    LAS unsigned char* lds = (LAS unsigned char*)lds_raw;
    cg::grid_group grid = cg::this_grid();
    unsigned char* ws = p.ws;
    const int G = gridDim.x, bid = blockIdx.x;
    float* SS = (float*)(ws + WS_SS);
    bf16_t* XB = (bf16_t*)(ws + WS_XB);
    bf16_t* HB = (bf16_t*)(ws + WS_H);
    bf16_t* MIX = (bf16_t*)(ws + WS_MIX);
    const int lo = p.ph_lo, hi = p.ph_hi;
    volatile LAS unsigned* bst = (volatile LAS unsigned*)(lds + LDS_BYTES - 64);
    if (threadIdx.x == 0) { bst[0] = 0u; bst[1] = 0u; }
    __syncthreads();
    if (hi == 0x7fffffff) grid.sync();
    XcdBarrier xbar; xbar.bar = (unsigned*)(ws + WS_BAR); xbar.x = 0; xbar.st = bst;
    if (hi - lo > 1) xbar = xcd_barrier_post((unsigned*)(ws + WS_BAR), bst);
#define IN(k) (lo <= (k) && (k) < hi)
#define SEAM(k) do { if (IN(k) && IN((k) + 1)) xcd_barrier(xbar); } while (0)

    if (IN(0)) p0_prologue(p, lds);
    SEAM(0);
    if (IN(1)) {
        pg8::Gemm g{XB, (const bf16_t*)(ws + WS_WGU1), T_TOK, 2 * DFF, DM}; pg8::StaticOrder S; S.init(T_TOK, 2 * DFF, G, bid);
        if (threadIdx.x == 0) *(LAS int*)(lds + 131072 + 8192 + 1024) = -1;
        __syncthreads();
        pg8::EpiSwiglu E{HB, SS, lds + 131072 + 8192};
        pg8::gemm_phase<pg8::EpiSwiglu, pg8::StaticOrder, true, true>(lds, g, S, E);
    }
    SEAM(1);
    if (IN(2)) {
        pg8::Gemm g{HB, (const bf16_t*)(ws + WS_WD1), T_TOK, DM, DFF}; pg8::StaticOrder S; S.init(T_TOK, DM, G, bid);
        pg8::EpiResid<false> E{nullptr, nullptr, XB, SS + (size_t)16 * T_TOK, 0.5f};
        pg8::gemm_phase<pg8::EpiResid<false>, pg8::StaticOrder, true, true>(lds, g, S, E);
    }
    SEAM(2);
    if (IN(3)) {
        pg8::Gemm g{XB, (const bf16_t*)(ws + WS_WIN), T_TOK, NIN_PAD, DM}; pg8::StaticOrder S; S.init(T_TOK, NIN_PAD, G, bid);
        if (threadIdx.x == 0) *(LAS int*)(lds + 131072 + 8192 + 1024) = -1;
        __syncthreads();
        pg8::EpiIn E{(bf16_t*)(ws + WS_P), (float*)(ws + WS_R), SS + (size_t)16 * T_TOK, lds + 131072 + 8192};
        pg8::gemm_phase<pg8::EpiIn, pg8::StaticOrder, true, true>(lds, g, S, E);
    }
    SEAM(3);
    if (IN(4)) {
        p4_gla_phase(p, lds);
    }
    SEAM(4);
    if (IN(5)) {
        bf16_t* ST = (bf16_t*)(ws + WS_ST); const float* DEC = (const float*)(ws + WS_DEC);
        for (int task = bid; task < 256; task += G) {
            if (task < 128) { const int chain = task >> 4, slice = task & 15; p5_scan<1, 16>(ST, DEC, chain >> 1, chain & 1, 0, 256, slice * 512 + (int)threadIdx.x); }
            else { const int idx = task - 128, chain = idx >> 1, half = idx & 1, seq = chain >> 3; p5_scan<8, 4>(ST, DEC, (chain & 7) >> 1, chain & 1, 256 + seq * 32, 32, (half * 512 + (int)threadIdx.x) * 8); }
        }
    }
    SEAM(5);
    if (IN(6)) {
        p6_gla_phase(p, lds);
    }
    SEAM(6);
    if (IN(7)) {
        pg8::Gemm g{MIX, (const bf16_t*)(ws + WS_WOUT), T_TOK, DM, DM}; pg8::StaticOrder S; S.init(T_TOK, DM, G, bid);
        pg8::EpiResid<false> E{nullptr, nullptr, XB, SS + (size_t)32 * T_TOK, 1.0f};
        pg8::gemm_phase<pg8::EpiResid<false>, pg8::StaticOrder, true, true>(lds, g, S, E);
    }
    SEAM(7);
    if (IN(8)) {
        pg8::Gemm g{XB, (const bf16_t*)(ws + WS_WGU2), T_TOK, 2 * DFF, DM}; pg8::StaticOrder S; S.init(T_TOK, 2 * DFF, G, bid);
        if (threadIdx.x == 0) *(LAS int*)(lds + 131072 + 8192 + 1024) = -1;
        __syncthreads();
        pg8::EpiSwiglu E{HB, SS + (size_t)32 * T_TOK, lds + 131072 + 8192};
        pg8::gemm_phase<pg8::EpiSwiglu, pg8::StaticOrder, true, true>(lds, g, S, E);
    }
    SEAM(8);
    if (IN(9)) {
        pg8::Gemm g{HB, (const bf16_t*)(ws + WS_WD2), T_TOK, DM, DFF}; pg8::StaticOrder S; S.init(T_TOK, DM, G, bid);
        pg8::EpiFinal E{XB, p.out, p.final_norm, SS + (size_t)48 * T_TOK, (unsigned*)(ws + WS_BAR) + 3584, 0.5f, lds + 131072};
        pg8::gemm_phase<pg8::EpiFinal, pg8::StaticOrder, true, true>(lds, g, S, E);
    }
#undef IN
#undef SEAM
}

#ifndef PHASE_MASK
#define PHASE_MASK 0x7FF
#endif
#ifndef N_LAUNCH_MODE
#define N_LAUNCH_MODE 1
#endif
extern "C" void kernel_launch(void* const* d_in, const int* in_sizes, int n_in, void* d_out, int out_size, void* d_ws, size_t ws_size, hipStream_t stream) {
    static int grid = 0;
    if (grid == 0) {
        int dev = 0, cus = 0, per_cu = 0;
        if (hipGetDevice(&dev) != hipSuccess || hipDeviceGetAttribute(&cus, hipDeviceAttributeMultiprocessorCount, dev) != hipSuccess) { fprintf(stderr, "device query failed\n"); grid = -1; return; }
        if (hipFuncSetAttribute((const void*)fwd_megakernel, hipFuncAttributeMaxDynamicSharedMemorySize, LDS_BYTES) != hipSuccess) { fprintf(stderr, "hipFuncSetAttribute failed\n"); grid = -1; return; }
        if (hipOccupancyMaxActiveBlocksPerMultiprocessor(&per_cu, (const void*)fwd_megakernel, 512, LDS_BYTES) != hipSuccess || per_cu < 1) { fprintf(stderr, "occupancy query: %d\n", per_cu); per_cu = 1; }
        (void)hipGetLastError();
        grid = cus * per_cu;
        if (n_in != 21 || ws_size < WS_END) { fprintf(stderr, "unexpected n_in %d / ws %zu (need %zu)\n", n_in, ws_size, (size_t)WS_END); grid = -1; return; }
    }
    if (grid < 0) return;
    Params p{};
    const float** pp = (const float**)&p;
    for (int i = 0; i < 21; ++i) pp[i] = (const float*)d_in[i];
    p.out = (float*)d_out; p.ws = (unsigned char*)d_ws;
    if (hipMemsetAsync((char*)d_ws + WS_BAR, 0, 16384, stream) != hipSuccess) { fprintf(stderr, "memset of barrier words failed\n"); return; }
#if N_LAUNCH_MODE == 1
    p.ph_lo = 0; p.ph_hi = 11;
    void* args[] = {&p};
    hipError_t e = hipLaunchCooperativeKernel((const void*)fwd_megakernel, dim3(grid), dim3(512), args, LDS_BYTES, stream);
    if (e != hipSuccess) fprintf(stderr, "cooperative launch failed: %s (grid %d)\n", hipGetErrorString(e), grid);
#else
    for (int k = 0; k < 11; ++k) { if (!((PHASE_MASK >> k) & 1)) continue; p.ph_lo = k; p.ph_hi = k + 1; hipLaunchKernelGGL(fwd_megakernel, dim3(grid), dim3(512), LDS_BYTES, stream, p); }
#endif
}
```

```cpp
#include <hip/hip_runtime.h>
#include <hip/hip_cooperative_groups.h>
#include <cstdio>
#include <cstdint>
namespace cg = cooperative_groups;

#define LAS __attribute__((address_space(3)))
typedef unsigned short bf16_t;
typedef short bf16x8 __attribute__((ext_vector_type(8)));
typedef float f32x4 __attribute__((ext_vector_type(4)));
typedef unsigned u32x4 __attribute__((ext_vector_type(4)));
typedef unsigned u32x2 __attribute__((ext_vector_type(2)));

constexpr int T_TOK = 32768, T_PROMPT = 16384, SAMPLE_LEN = 2048, DM = 1024, DFF = 2816, NIN_PAD = 3328;
constexpr int PLD = 2560;
constexpr int PQ = 0, PK = 256, PV = 512, PG = 1024, PZ = 1536, PB = 2048;
constexpr int NCHUNK = 512;
constexpr float EPS = 1e-6f;
constexpr size_t WS_WGU1 = 0;
constexpr size_t WS_WD1 = WS_WGU1 + (size_t)2 * DFF * DM * 2;
constexpr size_t WS_WIN = WS_WD1 + (size_t)DM * DFF * 2;
constexpr size_t WS_WOUT = WS_WIN + (size_t)NIN_PAD * DM * 2;
constexpr size_t WS_WGU2 = WS_WOUT + (size_t)DM * DM * 2;
constexpr size_t WS_WD2 = WS_WGU2 + (size_t)2 * DFF * DM * 2;
constexpr size_t WS_SS = WS_WD2 + (size_t)DM * DFF * 2;
constexpr size_t WS_DEC = WS_SS + (size_t)4 * T_TOK * 16 * 4;
constexpr size_t WS_R = WS_DEC + (size_t)NCHUNK * 4 * 2 * 64 * 4;
constexpr size_t WS_XB = WS_R + (size_t)T_TOK * 32 * 4;
constexpr size_t WS_H = WS_XB + (size_t)T_TOK * DM * 2;
constexpr size_t WS_P = WS_H + (size_t)T_TOK * DFF * 2;
constexpr size_t WS_BAR = WS_P + (size_t)T_TOK * PLD * 2;
constexpr size_t WS_END = WS_BAR + 16384;
constexpr size_t WS_MIX = WS_H;
constexpr size_t WS_ST = WS_H + (size_t)T_TOK * DM * 2;
static_assert(WS_ST + (size_t)NCHUNK * 4 * 2 * 8192 * 2 <= WS_P, "overlay");

struct Params {
    const float *x_prompt, *x_sample, *ffn1_norm, *ffn1_wg, *ffn1_wu, *ffn1_wd, *mix_norm, *w_in, *gfw, *gfb, *gbw, *gbb, *gla_norm, *conv_w, *conv_norm, *w_out,
        *ffn2_norm, *ffn2_wg, *ffn2_wu, *ffn2_wd, *final_norm;
    float* out; unsigned char* ws;
    int ph_lo, ph_hi;
};

typedef float f32x2_t __attribute__((ext_vector_type(2)));
typedef __bf16 bf16x2_t __attribute__((ext_vector_type(2)));
__device__ __forceinline__ unsigned cvt_pk_bf16(float lo, float hi) { const f32x2_t v = {lo, hi}; const bf16x2_t b = __builtin_convertvector(v, bf16x2_t); return __builtin_bit_cast(unsigned, b); }
__device__ __forceinline__ float bf_lo(unsigned u) { return __uint_as_float(u << 16); }
__device__ __forceinline__ float bf_hi(unsigned u) { return __uint_as_float(u & 0xffff0000u); }
__device__ __forceinline__ float silu_f(float g) { return g * __builtin_amdgcn_rcpf(1.0f + __expf(-g)); }

__device__ __forceinline__ float row_ss(const float* ssp, int row) {
    const f32x4 a = *(const f32x4*)(ssp + (size_t)row * 16), b = *(const f32x4*)(ssp + (size_t)row * 16 + 4), c = *(const f32x4*)(ssp + (size_t)row * 16 + 8), d = *(const f32x4*)(ssp + (size_t)row * 16 + 12);
    return ((a[0] + a[1]) + (a[2] + a[3])) + ((b[0] + b[1]) + (b[2] + b[3])) + ((c[0] + c[1]) + (c[2] + c[3])) + ((d[0] + d[1]) + (d[2] + d[3]));
}

__device__ __forceinline__ const LAS float* panel_scales(LAS unsigned char* xl, const float* ss, int pm) {
    const int t0 = __builtin_amdgcn_readfirstlane(*(LAS int*)(xl + 1024)), t1 = __builtin_amdgcn_readfirstlane(*(LAS int*)(xl + 2048 + 1024));
    if (t0 == pm) return (const LAS float*)xl;
    if (t1 == pm) return (const LAS float*)(xl + 2048);
    LAS float* RSL = (LAS float*)xl; LAS int* tag = (LAS int*)(xl + 1024);
    const int tid = threadIdx.x;
    if (tid < 256) RSL[tid] = rsqrtf(row_ss(ss, pm * 256 + tid) * (1.0f / DM) + EPS);
    asm volatile("s_waitcnt lgkmcnt(0)" ::: "memory"); __builtin_amdgcn_s_barrier(); asm volatile("" ::: "memory");
    if (tid == 0) *tag = pm;
    asm volatile("s_waitcnt lgkmcnt(0)" ::: "memory"); __builtin_amdgcn_s_barrier(); asm volatile("" ::: "memory");
    return RSL;
}

namespace pg8 {
constexpr int BM = 256, BK = 64, HALF = 128, HTB = HALF * BK * 2, STAGE_BYTES = 8 * HTB, NXCD = 8, WGM = 8;
__host__ __device__ __forceinline__ int lds_byte(int r, int c) { const int st = (r >> 4) * 2 + (c >> 5), rr = r & 15, cc = c & 31, ob = rr * 64 + cc * 2; return st * 1024 + (ob ^ (((ob >> 9) & 1) << 5)); }
__host__ __device__ __forceinline__ void stage_rc(int b, int& R, int& C) { const int st = b / 1024, sb = b % 1024, swz = sb ^ (((sb >> 9) & 1) << 5); R = (st >> 1) * 16 + swz / 64; C = (st & 1) * 32 + (swz % 64) / 2; }
__host__ __device__ __forceinline__ int perm32(int rho) { const int n = rho >> 4, i = rho & 15; return 8 * (i >> 2) + 4 * n + (i & 3); }
struct Unit { int pm, pn; };
struct Gemm { const bf16_t* A; const bf16_t* Bt; int M, N, K; };
struct StaticOrder {
    int nM, nN, nwg, G, c;
    __host__ __device__ void init(int M, int N, int G_, int c_) { nM = M / BM; nN = N / BM; nwg = nM * nN; G = G_; c = c_; }
    __host__ __device__ bool next(int i, Unit& u) const {
        const long L = (long)i * G + c; if (L >= nwg) return false;
        int wgid = (int)L; { const int q = nwg / NXCD, r = nwg % NXCD, xcd = wgid % NXCD, off = wgid / NXCD; wgid = (xcd < r ? xcd * (q + 1) : r * (q + 1) + (xcd - r) * q) + off; }
        const int nig = WGM * nN, gid = wgid / nig, fm = gid * WGM, gsz = (nM - fm) < WGM ? (nM - fm) : WGM;
        u.pm = fm + ((wgid % nig) % gsz); u.pn = (wgid % nig) / gsz; return true;
    }
    __device__ __forceinline__ void a_ready(const Unit&) const {}
    __device__ __forceinline__ void done(const Unit&) const {}
};

template <class Epi, class Sched, bool ALIGN_EPI = false, bool SP2 = false>
__device__ __forceinline__ void gemm_phase(LAS unsigned char* lds, const Gemm g, const Sched& S, const Epi& E) {
    const int tid = threadIdx.x, wid = __builtin_amdgcn_readfirstlane(tid >> 6), lane = tid & 63, wr = wid >> 2, wc = wid & 3, fr = lane & 15, fq = lane >> 4;
    const int K = g.K, nt = K / BK;
    unsigned voffA[2], voffB[2];
#pragma unroll
    for (int i = 0; i < 2; ++i) { int R, C; stage_rc(tid * 16 + i * 8192, R, C); const int Rb = Epi::PERM ? ((R & ~31) + perm32(R & 31)) : R;
        voffA[i] = (unsigned)(R * K + C) * 2u; voffB[i] = (unsigned)(Rb * K + C) * 2u; }
    const size_t kstep = (size_t)(BK * 2);
    const size_t hstep = (size_t)HALF * K * 2;
    const size_t tstep = 2 * hstep;
    const unsigned ldsw = (unsigned)wid * 1024u;
    const int aoff = lds_byte(wr * 64 + fr, fq * 8), boff = lds_byte(wc * 32 + fr, fq * 8);
#define PG8_SA(b, h) (((b) * 2 + (h)) * HTB)
#define PG8_SB(b, h) ((4 + (b) * 2 + (h)) * HTB)
#define PG8_STAGE(bufoff, gbase, voff) do { _Pragma("unroll") for (int _i = 0; _i < 2; ++_i) \
        __builtin_amdgcn_global_load_lds((const unsigned*)((const char*)(gbase) + (voff)[_i]), (LAS unsigned*)(lds + (bufoff) + ldsw + _i * 8192), 16, 0, 0); } while (0)
#define PG8_LDA(dst, b, h) do { _Pragma("unroll") for (int m = 0; m < 4; ++m) _Pragma("unroll") for (int k = 0; k < 2; ++k) dst[m][k] = *(const LAS bf16x8*)(lds + PG8_SA(b, h) + aoff + m * 2048 + k * 1024); } while (0)
#define PG8_LDB(dst, b, h) do { _Pragma("unroll") for (int n = 0; n < 2; ++n) _Pragma("unroll") for (int k = 0; k < 2; ++k) dst[n][k] = *(const LAS bf16x8*)(lds + PG8_SB(b, h) + boff + n * 2048 + k * 1024); } while (0)
#define PG8_MMA(ai, bj, At, Bt) do { __builtin_amdgcn_s_setprio(1); _Pragma("unroll") for (int m = 0; m < 4; ++m) _Pragma("unroll") for (int n = 0; n < 2; ++n) _Pragma("unroll") for (int k = 0; k < 2; ++k) \
        acc[ai][bj][m][n] = __builtin_amdgcn_mfma_f32_16x16x32_bf16(Bt[n][k], At[m][k], acc[ai][bj][m][n], 0, 0, 0); __builtin_amdgcn_s_setprio(0); } while (0)
#define PG8_WAIT_V(n) asm volatile("s_waitcnt vmcnt(" #n ")" ::: "memory")
#define PG8_WAIT_L(n) asm volatile("s_waitcnt lgkmcnt(" #n ")" ::: "memory")
#define PG8_BAR __builtin_amdgcn_s_barrier()
#define PG8_SCHED __builtin_amdgcn_sched_barrier(0)
    Unit cur, nxt; int ui = 0;
    if (!S.next(0, cur)) return;
    if constexpr (Epi::STAGGER) { const int slot = (blockIdx.x >> 3) & 7; for (int i = 0; i < slot; ++i) __builtin_amdgcn_s_sleep(32); }
    f32x4 acc[2][2][4][2];
#pragma unroll
    for (int a = 0; a < 2; ++a)
#pragma unroll
        for (int b = 0; b < 2; ++b)
#pragma unroll
            for (int m = 0; m < 4; ++m)
#pragma unroll
                for (int n = 0; n < 2; ++n) acc[a][b][m][n] = (f32x4){0.f, 0.f, 0.f, 0.f};
    bf16x8 At[4][2], B0[2][2], B1[2][2];
    const char* cA = (const char*)g.A + (size_t)cur.pm * tstep; const char* cB = (const char*)g.Bt + (size_t)cur.pn * tstep;
    S.a_ready(cur);
    if constexpr (SP2) {
        PG8_STAGE(PG8_SB(0, 0), cB, voffB); PG8_STAGE(PG8_SB(0, 1), cB + hstep, voffB); PG8_STAGE(PG8_SA(0, 0), cA, voffA); PG8_STAGE(PG8_SA(0, 1), cA + hstep, voffA);
        if (wr == 1) PG8_BAR;
        PG8_WAIT_V(2); PG8_BAR;
        PG8_STAGE(PG8_SB(1, 0), cB + kstep, voffB); PG8_STAGE(PG8_SA(1, 0), cA + kstep, voffA); PG8_STAGE(PG8_SB(1, 1), cB + hstep + kstep, voffB);
        PG8_WAIT_V(6); PG8_BAR;
    } else {
        PG8_STAGE(PG8_SB(0, 0), cB, voffB); PG8_STAGE(PG8_SA(0, 0), cA, voffA); PG8_STAGE(PG8_SB(0, 1), cB + hstep, voffB); PG8_STAGE(PG8_SA(0, 1), cA + hstep, voffA);
        if (wr == 1) PG8_BAR;
        PG8_WAIT_V(4); PG8_BAR;
        PG8_STAGE(PG8_SB(1, 0), cB + kstep, voffB); PG8_STAGE(PG8_SA(1, 0), cA + kstep, voffA); PG8_STAGE(PG8_SB(1, 1), cB + hstep + kstep, voffB);
        PG8_WAIT_V(6); PG8_BAR;
    }
    for (;;) {
        const bool has_next = S.next(ui + 1, nxt);
        const char* nA = has_next ? (const char*)g.A + (size_t)nxt.pm * tstep : cA; const char* nB = has_next ? (const char*)g.Bt + (size_t)nxt.pn * tstep : cB;
        for (int t = 0; t < nt; t += 2) {
            const bool last = (t == nt - 2);
            const char* a1 = cA + (size_t)(t + 1) * kstep;
            const char* a2 = last ? nA : cA + (size_t)(t + 2) * kstep; const char* b2 = last ? nB : cB + (size_t)(t + 2) * kstep;
            const char* a3 = a2 + kstep; const char* b3 = b2 + kstep;
            if (last && has_next) S.a_ready(nxt);
            if constexpr (SP2) {
            PG8_LDB(B0, 0, 0); PG8_LDB(B1, 0, 1); PG8_SCHED; PG8_LDA(At, 0, 0); PG8_STAGE(PG8_SA(1, 1), a1 + hstep, voffA);
            PG8_WAIT_V(8); PG8_WAIT_L(0); PG8_BAR; PG8_MMA(0, 0, At, B0); PG8_MMA(0, 1, At, B1); PG8_BAR; PG8_SCHED;
            PG8_LDA(At, 0, 1); PG8_STAGE(PG8_SB(0, 0), b2, voffB); PG8_STAGE(PG8_SB(0, 1), b2 + hstep, voffB); PG8_STAGE(PG8_SA(0, 0), a2, voffA);
            PG8_WAIT_V(8); PG8_WAIT_L(0); PG8_BAR; PG8_MMA(1, 0, At, B0); PG8_MMA(1, 1, At, B1); PG8_BAR; PG8_SCHED;
            PG8_LDB(B0, 1, 0); PG8_LDB(B1, 1, 1); PG8_SCHED; PG8_LDA(At, 1, 0); PG8_STAGE(PG8_SA(0, 1), a2 + hstep, voffA);
            PG8_WAIT_V(8); PG8_WAIT_L(0); PG8_BAR; PG8_MMA(0, 0, At, B0); PG8_MMA(0, 1, At, B1); PG8_BAR; PG8_SCHED;
            PG8_LDA(At, 1, 1); PG8_STAGE(PG8_SB(1, 0), b3, voffB); PG8_STAGE(PG8_SB(1, 1), b3 + hstep, voffB); PG8_STAGE(PG8_SA(1, 0), a3, voffA);
            PG8_WAIT_V(8); PG8_WAIT_L(0); PG8_BAR; PG8_MMA(1, 0, At, B0); PG8_MMA(1, 1, At, B1); PG8_BAR; PG8_SCHED;
            } else {
            PG8_LDB(B0, 0, 0); PG8_SCHED; PG8_LDA(At, 0, 0); PG8_STAGE(PG8_SA(1, 1), a1 + hstep, voffA);
            PG8_WAIT_L(8); PG8_BAR; PG8_WAIT_L(0); PG8_MMA(0, 0, At, B0); PG8_BAR; PG8_SCHED;
            PG8_LDB(B1, 0, 1); PG8_STAGE(PG8_SB(0, 0), b2, voffB);
            PG8_BAR; PG8_WAIT_L(0); PG8_MMA(0, 1, At, B1); PG8_BAR;
            PG8_LDA(At, 0, 1); PG8_STAGE(PG8_SA(0, 0), a2, voffA);
            PG8_BAR; PG8_WAIT_L(0); PG8_MMA(1, 0, At, B0); PG8_BAR; PG8_SCHED;
            PG8_STAGE(PG8_SB(0, 1), b2 + hstep, voffB);
            PG8_WAIT_V(6); PG8_BAR; PG8_MMA(1, 1, At, B1); PG8_BAR;
            PG8_LDB(B0, 1, 0); PG8_SCHED; PG8_LDA(At, 1, 0); PG8_STAGE(PG8_SA(0, 1), a2 + hstep, voffA);
            PG8_WAIT_L(8); PG8_BAR; PG8_WAIT_L(0); PG8_MMA(0, 0, At, B0); PG8_BAR; PG8_SCHED;
            PG8_LDB(B1, 1, 1); PG8_STAGE(PG8_SB(1, 0), b3, voffB);
            PG8_BAR; PG8_WAIT_L(0); PG8_MMA(0, 1, At, B1); PG8_BAR;
            PG8_LDA(At, 1, 1); PG8_STAGE(PG8_SA(1, 0), a3, voffA);
            PG8_BAR; PG8_WAIT_L(0); PG8_MMA(1, 0, At, B0); PG8_BAR; PG8_SCHED;
            PG8_STAGE(PG8_SB(1, 1), b3 + hstep, voffB);
            PG8_WAIT_V(6); PG8_BAR; PG8_MMA(1, 1, At, B1); PG8_BAR;
            }
        }
        if constexpr (ALIGN_EPI) { if (wr == 0) PG8_BAR; }
        E(acc, cur, wr, wc, fr, fq);
        if (!has_next) break;
#pragma unroll
        for (int a = 0; a < 2; ++a)
#pragma unroll
            for (int b = 0; b < 2; ++b)
#pragma unroll
                for (int m = 0; m < 4; ++m)
#pragma unroll
                    for (int n = 0; n < 2; ++n) acc[a][b][m][n] = (f32x4){0.f, 0.f, 0.f, 0.f};
        cur = nxt; cA = nA; cB = nB; ++ui;
        if constexpr (ALIGN_EPI) { if (wr == 1) PG8_BAR; }
    }
    PG8_WAIT_V(0);
    if constexpr (!ALIGN_EPI) { if (wr == 0) PG8_BAR; }
    PG8_BAR;
#undef PG8_SA
#undef PG8_SB
#undef PG8_STAGE
#undef PG8_LDA
#undef PG8_LDB
#undef PG8_MMA
#undef PG8_WAIT_V
#undef PG8_WAIT_L
#undef PG8_BAR
#undef PG8_SCHED
}

struct EpiSwiglu {
    static constexpr bool PERM = true, STAGGER = false;
    bf16_t* H; const float* ss; LAS unsigned char* xl;
    __device__ __forceinline__ void operator()(const f32x4 (&acc)[2][2][4][2], const Unit& u, int wr, int wc, int fr, int fq) const {
        const int row0 = u.pm * BM + wr * 64 + fr, col0 = u.pn * 128 + wc * 32 + 8 * fq;
        const LAS float* RSL = panel_scales(xl, ss, u.pm);
#pragma unroll
        for (int ai = 0; ai < 2; ++ai)
#pragma unroll
            for (int m = 0; m < 4; ++m) {
                const int row = row0 + ai * HALF + m * 16;
                const float rs = RSL[wr * 64 + fr + ai * HALF + m * 16];
                const float c1 = rs * -1.44269504089f, rs2 = rs * rs;
                f32x2_t hv[4];
#pragma unroll
                for (int n = 0; n < 2; ++n)
#pragma unroll
                    for (int q = 0; q < 2; ++q) {
                        const f32x2_t g2 = {acc[ai][0][m][n][2 * q], acc[ai][0][m][n][2 * q + 1]}, u2 = {acc[ai][1][m][n][2 * q], acc[ai][1][m][n][2 * q + 1]};
                        const f32x2_t a = g2 * c1; f32x2_t e; e.x = __builtin_amdgcn_exp2f(a.x); e.y = __builtin_amdgcn_exp2f(a.y);
                        const f32x2_t d = e + 1.0f; f32x2_t r; r.x = __builtin_amdgcn_rcpf(d.x); r.y = __builtin_amdgcn_rcpf(d.y);
                        hv[n * 2 + q] = (g2 * u2) * (r * rs2);
                    }
                u32x4 w; w.x = cvt_pk_bf16(hv[0].x, hv[0].y); w.y = cvt_pk_bf16(hv[1].x, hv[1].y); w.z = cvt_pk_bf16(hv[2].x, hv[2].y); w.w = cvt_pk_bf16(hv[3].x, hv[3].y);
                *(u32x4*)(H + (size_t)row * DFF + col0) = w;
            }
    }
};
template <bool BASE_F32> struct EpiResid {
    static constexpr bool PERM = true, STAGGER = false;
    const float* base_lo; const float* base_hi;
    bf16_t* xb; float* ss_out; float alpha;
    __device__ __forceinline__ void operator()(const f32x4 (&acc)[2][2][4][2], const Unit& u, int wr, int wc, int fr, int fq) const {
        const int row0 = u.pm * BM + wr * 64 + fr, col0 = u.pn * BM + wc * 32 + 8 * fq;
#pragma unroll
        for (int ai = 0; ai < 2; ++ai) {
            f32x4 bf[BASE_F32 ? 4 : 1][2][2]; u32x4 bh[BASE_F32 ? 1 : 4][2];
#pragma unroll
            for (int m = 0; m < 4; ++m) {
                const int row = row0 + ai * HALF + m * 16;
                if (BASE_F32) {
                    const float* bp = (row < T_PROMPT ? base_lo + (size_t)row * DM : base_hi + (size_t)(row - T_PROMPT) * DM) + col0;
#pragma unroll
                    for (int bj = 0; bj < 2; ++bj)
#pragma unroll
                        for (int n = 0; n < 2; ++n) bf[BASE_F32 ? m : 0][bj][n] = *(const f32x4*)(bp + bj * HALF + n * 4);
                } else {
                    const bf16_t* xp = xb + (size_t)row * DM + col0;
#pragma unroll
                    for (int bj = 0; bj < 2; ++bj) bh[BASE_F32 ? 0 : m][bj] = *(const u32x4*)(xp + bj * HALF);
                }
            }
            asm volatile("" ::: "memory");
#pragma unroll
            for (int m = 0; m < 4; ++m) {
                const int row = row0 + ai * HALF + m * 16;
                bf16_t* xp = xb + (size_t)row * DM + col0;
                float sq = 0.f;
#pragma unroll
                for (int bj = 0; bj < 2; ++bj) {
                    f32x4 b0, b1;
                    if (BASE_F32) { b0 = bf[BASE_F32 ? m : 0][bj][0]; b1 = bf[BASE_F32 ? m : 0][bj][1]; }
                    else { const u32x4 v = bh[BASE_F32 ? 0 : m][bj]; b0 = (f32x4){bf_lo(v.x), bf_hi(v.x), bf_lo(v.y), bf_hi(v.y)}; b1 = (f32x4){bf_lo(v.z), bf_hi(v.z), bf_lo(v.w), bf_hi(v.w)}; }
                    const f32x4 o0 = b0 + acc[ai][bj][m][0] * alpha, o1 = b1 + acc[ai][bj][m][1] * alpha;
                    u32x4 w; w.x = cvt_pk_bf16(o0[0], o0[1]); w.y = cvt_pk_bf16(o0[2], o0[3]); w.z = cvt_pk_bf16(o1[0], o1[1]); w.w = cvt_pk_bf16(o1[2], o1[3]);
                    *(u32x4*)(xp + bj * HALF) = w;
                    sq += ((o0[0] * o0[0] + o0[1] * o0[1]) + (o0[2] * o0[2] + o0[3] * o0[3])) + ((o1[0] * o1[0] + o1[1] * o1[1]) + (o1[2] * o1[2] + o1[3] * o1[3]));
                }
                sq += __shfl_xor(sq, 16); sq += __shfl_xor(sq, 32);
                if (fq == 0) ss_out[(size_t)row * 16 + u.pn * 4 + wc] = sq;
            }
        }
    }
};
struct EpiFinal {
    static constexpr bool PERM = true, STAGGER = false;
    const bf16_t* xb; float* out; const float* gain; float* xslot; unsigned* cnt; float alpha; LAS unsigned char* xl;
    __device__ __forceinline__ void operator()(f32x4 (&acc)[2][2][4][2], const Unit& u, int wr, int wc, int fr, int fq) const {
        LAS float* PL = (LAS float*)xl;
        LAS float* SL = (LAS float*)(xl + 4096);
        const int tid = threadIdx.x, lane = tid & 63, wid = __builtin_amdgcn_readfirstlane(tid >> 6);
        const int row0 = u.pm * BM + wr * 64 + fr, col0 = u.pn * BM + wc * 32 + 8 * fq;
#pragma unroll
        for (int ai = 0; ai < 2; ++ai)
#pragma unroll
            for (int m = 0; m < 4; ++m) {
                const int row = row0 + ai * HALF + m * 16;
                const bf16_t* xp = xb + (size_t)row * DM + col0;
                float sq = 0.f;
#pragma unroll
                for (int bj = 0; bj < 2; ++bj) {
                    const u32x4 v = *(const u32x4*)(xp + bj * HALF);
                    const f32x4 o0 = (f32x4){bf_lo(v.x), bf_hi(v.x), bf_lo(v.y), bf_hi(v.y)} + acc[ai][bj][m][0] * alpha;
                    const f32x4 o1 = (f32x4){bf_lo(v.z), bf_hi(v.z), bf_lo(v.w), bf_hi(v.w)} + acc[ai][bj][m][1] * alpha;
                    acc[ai][bj][m][0] = o0; acc[ai][bj][m][1] = o1;
                    sq += ((o0[0] * o0[0] + o0[1] * o0[1]) + (o0[2] * o0[2] + o0[3] * o0[3])) + ((o1[0] * o1[0] + o1[1] * o1[1]) + (o1[2] * o1[2] + o1[3] * o1[3]));
                }
                sq += __shfl_xor(sq, 16); sq += __shfl_xor(sq, 32);
                if (fq == 0) PL[(ai * HALF + wr * 64 + m * 16 + fr) * 4 + wc] = sq;
            }
        asm volatile("s_waitcnt lgkmcnt(0)" ::: "memory"); __builtin_amdgcn_s_barrier(); asm volatile("" ::: "memory");
        if (tid < 256) {
            const f32x4 v = *(const LAS f32x4*)(PL + tid * 4);
            __hip_atomic_store(xslot + (size_t)(u.pm * BM + tid) * 16 + u.pn, (v[0] + v[1]) + (v[2] + v[3]), __ATOMIC_RELAXED, __HIP_MEMORY_SCOPE_AGENT);
        }
        asm volatile("s_waitcnt vmcnt(0)" ::: "memory");
        if (wid < 4 && lane == 0) __hip_atomic_fetch_add(cnt + u.pm, 1u, __ATOMIC_RELAXED, __HIP_MEMORY_SCOPE_AGENT);
        if (wid == 0) {
            unsigned sp = 0;
            while ((unsigned)__builtin_amdgcn_readfirstlane(__hip_atomic_load(cnt + u.pm, __ATOMIC_RELAXED, __HIP_MEMORY_SCOPE_AGENT)) < 16u) { __builtin_amdgcn_s_sleep(2); if (++sp > (1u << 20)) break; }
            __builtin_amdgcn_fence(__ATOMIC_ACQUIRE, "agent");
            asm volatile("s_waitcnt vmcnt(0)" ::: "memory");
        }
        asm volatile("s_waitcnt vmcnt(0) lgkmcnt(0)" ::: "memory"); __builtin_amdgcn_s_barrier(); asm volatile("" ::: "memory");
        if (tid < 256) {
            const float* sl = xslot + (size_t)(u.pm * BM + tid) * 16;
            const float t = (__hip_atomic_load(sl + 0, __ATOMIC_RELAXED, __HIP_MEMORY_SCOPE_AGENT) + __hip_atomic_load(sl + 1, __ATOMIC_RELAXED, __HIP_MEMORY_SCOPE_AGENT))
                          + (__hip_atomic_load(sl + 2, __ATOMIC_RELAXED, __HIP_MEMORY_SCOPE_AGENT) + __hip_atomic_load(sl + 3, __ATOMIC_RELAXED, __HIP_MEMORY_SCOPE_AGENT));
            SL[tid] = rsqrtf(t * (1.0f / DM) + EPS);
        }
        asm volatile("s_waitcnt lgkmcnt(0)" ::: "memory"); __builtin_amdgcn_s_barrier(); asm volatile("" ::: "memory");
        f32x4 gv[2][2];
#pragma unroll
        for (int bj = 0; bj < 2; ++bj)
#pragma unroll
            for (int n = 0; n < 2; ++n) gv[bj][n] = *(const f32x4*)(gain + col0 + bj * HALF + n * 4);
#pragma unroll
        for (int ai = 0; ai < 2; ++ai)
#pragma unroll
            for (int m = 0; m < 4; ++m) {
                const int r = ai * HALF + wr * 64 + m * 16 + fr;
                const float rs = SL[r];
                float* op = out + (size_t)(u.pm * BM + r) * DM + col0;
#pragma unroll
                for (int bj = 0; bj < 2; ++bj)
#pragma unroll
                    for (int n = 0; n < 2; ++n) *(f32x4*)(op + bj * HALF + n * 4) = acc[ai][bj][m][n] * rs * gv[bj][n];
            }
    }
};
struct EpiIn {
    static constexpr bool PERM = true, STAGGER = false;
    bf16_t* P; float* R; const float* ss; LAS unsigned char* xl;
    __device__ __forceinline__ void operator()(const f32x4 (&acc)[2][2][4][2], const Unit& u, int wr, int wc, int fr, int fq) const {
        const int row0 = u.pm * BM + wr * 64 + fr; const int pn = u.pn;
        const LAS float* RSL = panel_scales(xl, ss, u.pm);
#pragma unroll
        for (int ai = 0; ai < 2; ++ai)
#pragma unroll
            for (int m = 0; m < 4; ++m) {
                const int row = row0 + ai * HALF + m * 16;
                const float rs = RSL[wr * 64 + fr + ai * HALF + m * 16];
                if (pn < 6 || pn == 10 || pn == 11) {
                    const float sc = (pn == 0) ? rs * 0.125f : rs;
                    const int cbase = (pn < 6 ? pn * 256 : PB + (pn - 10) * 256) + wc * 32 + 8 * fq;
#pragma unroll
                    for (int bj = 0; bj < 2; ++bj) {
                        const f32x4 v0 = acc[ai][bj][m][0] * sc, v1 = acc[ai][bj][m][1] * sc;
                        u32x4 w; w.x = cvt_pk_bf16(v0[0], v0[1]); w.y = cvt_pk_bf16(v0[2], v0[3]); w.z = cvt_pk_bf16(v1[0], v1[1]); w.w = cvt_pk_bf16(v1[2], v1[3]);
                        *(u32x4*)(P + (size_t)row * PLD + cbase + bj * HALF) = w;
                    }
                } else if (pn < 10) {
                    const float s2 = rs * rs;
                    const f32x4 v0 = acc[ai][0][m][0] * acc[ai][1][m][0] * s2, v1 = acc[ai][0][m][1] * acc[ai][1][m][1] * s2;
                    u32x4 w; w.x = cvt_pk_bf16(v0[0], v0[1]); w.y = cvt_pk_bf16(v0[2], v0[3]); w.z = cvt_pk_bf16(v1[0], v1[1]); w.w = cvt_pk_bf16(v1[2], v1[3]);
                    *(u32x4*)(P + (size_t)row * PLD + PZ + (pn - 6) * 128 + wc * 32 + 8 * fq) = w;
                } else {
                    if (wc == 0) {
                        *(f32x4*)(R + (size_t)row * 32 + 8 * fq) = acc[ai][0][m][0] * rs;
                        *(f32x4*)(R + (size_t)row * 32 + 8 * fq + 4) = acc[ai][0][m][1] * rs;
                    }
                }
            }
    }
};
}

template <class Sched> __device__ __forceinline__ void panel_prefill(LAS unsigned char* xl, const float* ss, const Sched& S) {
    pg8::Unit u; int pmA = -1, pmB = -1;
    for (int i = 0; S.next(i, u); ++i) { if (pmA < 0) pmA = u.pm; else if (u.pm != pmA && pmB < 0) pmB = u.pm; }
    const int tid = threadIdx.x;
    if (tid < 256) { if (pmA >= 0) ((LAS float*)xl)[tid] = rsqrtf(row_ss(ss, pmA * 256 + tid) * (1.0f / DM) + EPS); }
    else { if (pmB >= 0) ((LAS float*)(xl + 2048))[tid - 256] = rsqrtf(row_ss(ss, pmB * 256 + tid - 256) * (1.0f / DM) + EPS); }
    if (tid == 0) { *(LAS int*)(xl + 1024) = pmA; *(LAS int*)(xl + 2048 + 1024) = pmB; }
    __syncthreads();
}

__device__ __forceinline__ void transpose_item(const float* W, int N, int src_col0, const float* gain, bf16_t* WT, int K, int dst_row0, int k0, LAS float* scr, int lane) {
    const int c = lane & 7;
    if (src_col0 < 0) {
#pragma unroll
        for (int j = 0; j < 4; ++j) { const int n = (lane >> 3) + 8 * j; *(u32x4*)(WT + (size_t)(dst_row0 + n) * K + k0 + 8 * c) = (u32x4){0u, 0u, 0u, 0u}; }
        return;
    }
#pragma unroll 16
    for (int i = 0; i < 32; ++i) { const int kk = 2 * i + (lane >> 5); const float gm = gain ? gain[k0 + kk] : 1.0f; scr[kk * 33 + (lane & 31)] = W[(size_t)(k0 + kk) * N + src_col0 + (lane & 31)] * gm; }
    asm volatile("s_waitcnt lgkmcnt(0)" ::: "memory");
#pragma unroll
    for (int j = 0; j < 4; ++j) { const int n = (lane >> 3) + 8 * j; const LAS float* s = scr + (8 * c) * 33 + n;
        u32x4 o; o.x = cvt_pk_bf16(s[0 * 33], s[1 * 33]); o.y = cvt_pk_bf16(s[2 * 33], s[3 * 33]); o.z = cvt_pk_bf16(s[4 * 33], s[5 * 33]); o.w = cvt_pk_bf16(s[6 * 33], s[7 * 33]);
        *(u32x4*)(WT + (size_t)(dst_row0 + n) * K + k0 + 8 * c) = o; }
    asm volatile("s_waitcnt lgkmcnt(0)" ::: "memory");
}
__device__ __forceinline__ void transpose_matrix_item(int kind, const float* W, const float* W2, int Nsrc, const float* gain, bf16_t* WT, int K, int Ndst, int item, LAS float* scr, int lane) {
    const int nblk = Ndst / 32, kb = item / nblk, nb = item % nblk, n0 = nb * 32, k0 = kb * 64;
    const float* src = W; int col = n0;
    if (kind == 0) { const int tile = n0 >> 8, within = n0 & 255; if (within < 128) { col = tile * 128 + within; } else { src = W2; col = tile * 128 + within - 128; } }
    else if (kind == 2) {
        if (n0 < 1536) col = n0;
        else if (n0 < 2560) { const int tile = (n0 - 1536) >> 8, within = (n0 - 1536) & 255; col = (within < 128) ? 2080 + tile * 128 + within : 2592 + tile * 128 + within - 128; }
        else if (n0 < 3072) col = 1568 + (n0 - 2560);
        else if (n0 < 3104) col = 1536 + (n0 - 3072);
        else col = -1;
    }
    transpose_item(src, Nsrc, col, gain, WT, K, n0, k0, scr, lane);
}
__device__ __forceinline__ float wave_sum(float v) {
#pragma unroll
    for (int o = 1; o < 64; o <<= 1) v += __shfl_xor(v, o);
    return v;
}

__device__ __forceinline__ void p0_prologue(const Params& p, LAS unsigned char* lds) {
    const int tid = threadIdx.x, wave = tid >> 6, lane = tid & 63;
    LAS float* scr = (LAS float*)(lds + wave * 16384);
    const int gw = blockIdx.x * 8 + wave, NGW = gridDim.x * 8;
    unsigned char* ws = p.ws;
    constexpr int I_GU = (DM / 64) * (2 * DFF / 32), I_D = (DFF / 64) * (DM / 32), I_IN = (DM / 64) * (NIN_PAD / 32), I_O = (DM / 64) * (DM / 32);
    constexpr int NITEMS = 2 * I_GU + 2 * I_D + I_IN + I_O;
    for (int it = gw; it < NITEMS; it += NGW) {
        int r = it;
        if (r < I_GU) { transpose_matrix_item(0, p.ffn1_wg, p.ffn1_wu, DFF, p.ffn1_norm, (bf16_t*)(ws + WS_WGU1), DM, 2 * DFF, r, scr, lane); continue; } r -= I_GU;
        if (r < I_GU) { transpose_matrix_item(0, p.ffn2_wg, p.ffn2_wu, DFF, p.ffn2_norm, (bf16_t*)(ws + WS_WGU2), DM, 2 * DFF, r, scr, lane); continue; } r -= I_GU;
        if (r < I_D) { transpose_matrix_item(1, p.ffn1_wd, nullptr, DM, nullptr, (bf16_t*)(ws + WS_WD1), DFF, DM, r, scr, lane); continue; } r -= I_D;
        if (r < I_D) { transpose_matrix_item(1, p.ffn2_wd, nullptr, DM, nullptr, (bf16_t*)(ws + WS_WD2), DFF, DM, r, scr, lane); continue; } r -= I_D;
        if (r < I_IN) { transpose_matrix_item(2, p.w_in, nullptr, 3104, p.mix_norm, (bf16_t*)(ws + WS_WIN), DM, NIN_PAD, r, scr, lane); continue; } r -= I_IN;
        transpose_matrix_item(1, p.w_out, nullptr, DM, nullptr, (bf16_t*)(ws + WS_WOUT), DM, DM, r, scr, lane);
    }
    float* SS = (float*)(ws + WS_SS);
    bf16_t* XB = (bf16_t*)(ws + WS_XB);
    for (int rowb = gw * 4; rowb < T_TOK; rowb += NGW * 4) {
        f32x4 v[4][4];
#pragma unroll
        for (int r = 0; r < 4; ++r) { const int row = rowb + r;
            const float* xr = (row < T_PROMPT) ? p.x_prompt + (size_t)row * DM : p.x_sample + (size_t)(row - T_PROMPT) * DM;
#pragma unroll
            for (int j = 0; j < 4; ++j) v[r][j] = *(const f32x4*)(xr + j * 256 + lane * 4); }
#pragma unroll
        for (int r = 0; r < 4; ++r) { const int row = rowb + r; float s = 0.f;
#pragma unroll
            for (int j = 0; j < 4; ++j) {
                s += (v[r][j][0] * v[r][j][0] + v[r][j][1] * v[r][j][1]) + (v[r][j][2] * v[r][j][2] + v[r][j][3] * v[r][j][3]);
                u32x2 w; w.x = cvt_pk_bf16(v[r][j][0], v[r][j][1]); w.y = cvt_pk_bf16(v[r][j][2], v[r][j][3]);
                *(u32x2*)(XB + (size_t)row * DM + j * 256 + lane * 4) = w;
            }
            s = wave_sum(s);
            if (lane < 16) SS[(size_t)row * 16 + lane] = (lane == 0) ? s : 0.f; }
    }
}

template <int CTRL> __device__ __forceinline__ float dpp0(float v) { return __builtin_bit_cast(float, __builtin_amdgcn_update_dpp(0, __builtin_bit_cast(int, v), CTRL, 0xf, 0xf, true)); }
__device__ __forceinline__ float rdlane(float v, int l) { return __builtin_bit_cast(float, __builtin_amdgcn_readlane(__builtin_bit_cast(int, v), l)); }
template <int CTRL, int RMASK> __device__ __forceinline__ float dppm(float v) { return __builtin_bit_cast(float, __builtin_amdgcn_update_dpp(0, __builtin_bit_cast(int, v), CTRL, RMASK, 0xf, false)); }
template <int DIR> __device__ __forceinline__ float lane_scan(float x, int lane, float& tot) {
    float v = x;
    v += dpp0<0x111>(v); v += dpp0<0x112>(v); v += dpp0<0x114>(v); v += dpp0<0x118>(v);
    v += dppm<0x142, 0xa>(v);
    v += dppm<0x143, 0xc>(v);
    tot = rdlane(v, 63);
    return DIR == 0 ? v : (tot - v) + x;
}
__device__ __forceinline__ float log_sigmoid_f(float z) { return fminf(z, 0.f) - 0.69314718056f * __builtin_amdgcn_logf(1.0f + __expf(-fabsf(z))); }

#define LDS_BARRIER() do { asm volatile("s_waitcnt lgkmcnt(0)" ::: "memory"); __builtin_amdgcn_s_barrier(); asm volatile("" ::: "memory"); } while (0)
constexpr int LD72 = 72, LDV = 136, LDR = 36;
constexpr int L_GW = 0, L_GB = 32768, L_RAWQ = 34816, L_RAWK = L_RAWQ + 64 * LD72 * 2, L_RAWV = L_RAWK + 64 * LD72 * 2, L_RAWR = L_RAWV + 64 * LDV * 2,
              L_QD = L_RAWR + 64 * LDR * 4, L_KI = L_QD + 2 * 64 * LD72 * 2, L_VT = L_KI + 2 * 64 * LD72 * 2, L_PP = L_VT + 128 * LD72 * 2, L_SSQ = L_PP + 64 * LD72 * 2, L_GLA_END = L_SSQ + 2048;
static_assert(L_GLA_END <= 147456 - 64, "GLA LDS map");

struct GlaRaw { u32x4 q, k, v0, v1, r; };
template <bool NEED_Q> __device__ __forceinline__ void gla_raw_load(const Params& p, int chunk, int h, int tid, GlaRaw& g) {
    const int row = tid >> 3, c = tid & 7; const size_t tok = (size_t)chunk * 64 + row;
    const bf16_t* pr = (const bf16_t*)(p.ws + WS_P) + tok * PLD;
    if (NEED_Q) g.q = *(const u32x4*)(pr + PQ + h * 64 + c * 8);
    g.k = *(const u32x4*)(pr + PK + h * 64 + c * 8);
    g.v0 = *(const u32x4*)(pr + PV + h * 128 + c * 8); g.v1 = *(const u32x4*)(pr + PV + h * 128 + 64 + c * 8);
    g.r = *(const u32x4*)((const float*)(p.ws + WS_R) + tok * 32 + c * 4);
}
template <bool NEED_Q> __device__ __forceinline__ void gla_raw_store(LAS unsigned char* lds, int tid, const GlaRaw& g) {
    const int row = tid >> 3, c = tid & 7;
    if (NEED_Q) *(LAS u32x4*)(lds + L_RAWQ + (row * LD72 + c * 8) * 2) = g.q;
    *(LAS u32x4*)(lds + L_RAWK + (row * LD72 + c * 8) * 2) = g.k;
    *(LAS u32x4*)(lds + L_RAWV + (row * LDV + c * 8) * 2) = g.v0; *(LAS u32x4*)(lds + L_RAWV + (row * LDV + 64 + c * 8) * 2) = g.v1;
    *(LAS u32x4*)(lds + L_RAWR + (row * LDR + c * 4) * 4) = g.r;
}
__device__ __forceinline__ void gla_stage_gates(const Params& p, LAS unsigned char* lds, int tid) {
#pragma unroll
    for (int j = 0; j < 4; ++j) { const int i = tid + j * 512;
        const f32x4 v = (i < 1024) ? *(const f32x4*)(p.gfw + (size_t)i * 4) : *(const f32x4*)(p.gbw + (size_t)(i - 1024) * 4);
        *(LAS f32x4*)(lds + L_GW + i * 16) = v; }
    if (tid < 128) { const f32x4 v = (tid < 64) ? *(const f32x4*)(p.gfb + tid * 4) : *(const f32x4*)(p.gbb + (tid - 64) * 4); *(LAS f32x4*)(lds + L_GB + tid * 16) = v; }
}

template <int MODE, int DIR> __device__ __forceinline__ void gla_prep(const Params& p, LAS unsigned char* lds, int chunk, int h, int w, int lane) {
    constexpr int dir = DIR; const int dg = w & 3;
    LAS bf16_t* VT = (LAS bf16_t*)(lds + L_VT);
    float rr[16];
#pragma unroll
    for (int j = 0; j < 4; ++j) { const f32x4 v = *(const LAS f32x4*)(lds + L_RAWR + (lane * LDR + dir * 16 + j * 4) * 4); rr[j * 4 + 0] = v[0]; rr[j * 4 + 1] = v[1]; rr[j * 4 + 2] = v[2]; rr[j * 4 + 3] = v[3]; }
    const u32x4 k0 = *(const LAS u32x4*)(lds + L_RAWK + (lane * LD72 + dg * 16) * 2), k1 = *(const LAS u32x4*)(lds + L_RAWK + (lane * LD72 + dg * 16 + 8) * 2);
    const u32x4 v0 = *(const LAS u32x4*)(lds + L_RAWV + (lane * LDV + w * 16) * 2), v1 = *(const LAS u32x4*)(lds + L_RAWV + (lane * LDV + w * 16 + 8) * 2);
    u32x4 q0 = (u32x4){0u, 0u, 0u, 0u}, q1 = q0;
    if (MODE == 1) { q0 = *(const LAS u32x4*)(lds + L_RAWQ + (lane * LD72 + dg * 16) * 2); q1 = *(const LAS u32x4*)(lds + L_RAWQ + (lane * LD72 + dg * 16 + 8) * 2); }
    const unsigned qq[8] = {q0.x, q0.y, q0.z, q0.w, q1.x, q1.y, q1.z, q1.w};
    const unsigned kk[8] = {k0.x, k0.y, k0.z, k0.w, k1.x, k1.y, k1.z, k1.w};
    const unsigned vv[8] = {v0.x, v0.y, v0.z, v0.w, v1.x, v1.y, v1.z, v1.w};
#pragma unroll
    for (int e = 0; e < 8; ++e) { VT[(w * 16 + 2 * e) * LD72 + lane] = (bf16_t)(vv[e] & 0xffffu); VT[(w * 16 + 2 * e + 1) * LD72 + lane] = (bf16_t)(vv[e] >> 16); }
    typedef const __attribute__((address_space(4))) float cfloat; typedef const __attribute__((address_space(4))) f32x4 cf32x4;
    cfloat* gwl = (cfloat*)(DIR ? p.gbw : p.gfw) + h * 64 + dg * 16;
    cfloat* gbl = (cfloat*)(DIR ? p.gbb : p.gfb) + h * 64 + dg * 16;
    float qd[16], ki[16]; float decv = 0.f;
#pragma unroll
    for (int c4 = 0; c4 < 4; ++c4) {
        f32x4 zz = *(cf32x4*)(gbl + c4 * 4);
#pragma unroll
        for (int r = 0; r < 16; ++r) { const f32x4 g = *(cf32x4*)(gwl + r * 256 + c4 * 4); zz = zz + g * rr[r]; }
#pragma unroll
        for (int e = 0; e < 4; ++e) {
            const int cc = c4 * 4 + e;
            const float la = log_sigmoid_f(zz[e]) * (1.0f / 16.0f);
            float tot; const float cum = lane_scan<DIR>(la, lane, tot);
            const float kv = (cc & 1) ? bf_hi(kk[cc >> 1]) : bf_lo(kk[cc >> 1]);
            if (MODE == 0) {
                const float kt = kv * __expf(tot - cum);
                ((LAS bf16_t*)(lds + L_QD))[(dir * 64 + dg * 16 + cc) * LD72 + lane] = (bf16_t)(cvt_pk_bf16(kt, 0.f) & 0xffffu);
                decv = (lane == cc) ? tot : decv;
            } else {
                const float qv = (cc & 1) ? bf_hi(qq[cc >> 1]) : bf_lo(qq[cc >> 1]);
                qd[cc] = qv * __expf(cum); ki[cc] = kv * __expf(-cum);
            }
        }
    }
    if (MODE == 0) { if (lane < 16) ((float*)(p.ws + WS_DEC))[((size_t)(chunk * 4 + h) * 2 + dir) * 64 + dg * 16 + lane] = __expf(decv); }
    if (MODE == 1) {
        LAS bf16_t* QD = (LAS bf16_t*)(lds + L_QD); LAS bf16_t* KI = (LAS bf16_t*)(lds + L_KI);
        u32x4 a, b;
        a.x = cvt_pk_bf16(qd[0], qd[1]); a.y = cvt_pk_bf16(qd[2], qd[3]); a.z = cvt_pk_bf16(qd[4], qd[5]); a.w = cvt_pk_bf16(qd[6], qd[7]);
        b.x = cvt_pk_bf16(qd[8], qd[9]); b.y = cvt_pk_bf16(qd[10], qd[11]); b.z = cvt_pk_bf16(qd[12], qd[13]); b.w = cvt_pk_bf16(qd[14], qd[15]);
        *(LAS u32x4*)(QD + (dir * 64 + lane) * LD72 + dg * 16) = a; *(LAS u32x4*)(QD + (dir * 64 + lane) * LD72 + dg * 16 + 8) = b;
        a.x = cvt_pk_bf16(ki[0], ki[1]); a.y = cvt_pk_bf16(ki[2], ki[3]); a.z = cvt_pk_bf16(ki[4], ki[5]); a.w = cvt_pk_bf16(ki[6], ki[7]);
        b.x = cvt_pk_bf16(ki[8], ki[9]); b.y = cvt_pk_bf16(ki[10], ki[11]); b.z = cvt_pk_bf16(ki[12], ki[13]); b.w = cvt_pk_bf16(ki[14], ki[15]);
        *(LAS u32x4*)(KI + (dir * 64 + lane) * LD72 + dg * 16) = a; *(LAS u32x4*)(KI + (dir * 64 + lane) * LD72 + dg * 16 + 8) = b;
    }
}

struct ConvW { float w0[8], w1[8], w2[8], gn[8]; };
struct ConvRows { u32x4 zc[2], zm[2], zp[2], bb[2]; };
__device__ __forceinline__ void conv_weights(const Params& p, int tid, ConvW& W) {
    const int ch0 = (tid & 63) * 8;
#pragma unroll
    for (int j = 0; j < 2; ++j) {
        const f32x4 a = *(const f32x4*)(p.conv_w + ch0 + j * 4), b = *(const f32x4*)(p.conv_w + 512 + ch0 + j * 4), c = *(const f32x4*)(p.conv_w + 1024 + ch0 + j * 4), g = *(const f32x4*)(p.conv_norm + ch0 + j * 4);
#pragma unroll
        for (int e = 0; e < 4; ++e) { W.w0[j * 4 + e] = a[e]; W.w1[j * 4 + e] = b[e]; W.w2[j * 4 + e] = c[e]; W.gn[j * 4 + e] = g[e]; }
    }
}
__device__ __forceinline__ void conv_load2(const Params& p, int chunk, int k0, int tid, ConvRows& R) {
    const bf16_t* P = (const bf16_t*)(p.ws + WS_P);
    const int ch0 = (tid & 63) * 8;
#pragma unroll
    for (int k = 0; k < 2; ++k) {
        const int t = chunk * 64 + (tid >> 6) + 8 * (k0 + k);
        const bool first = (t == 0) || (t >= T_PROMPT && ((t - T_PROMPT) & (SAMPLE_LEN - 1)) == 0);
        const bool last = (t == T_PROMPT - 1) || (t >= T_PROMPT && ((t - T_PROMPT) & (SAMPLE_LEN - 1)) == SAMPLE_LEN - 1);
        const bf16_t* pr = P + (size_t)t * PLD;
        R.zc[k] = *(const u32x4*)(pr + PZ + ch0);
        R.zm[k] = first ? (u32x4){0u, 0u, 0u, 0u} : *(const u32x4*)(pr - PLD + PZ + ch0);
        R.zp[k] = last ? (u32x4){0u, 0u, 0u, 0u} : *(const u32x4*)(pr + PLD + PZ + ch0);
        R.bb[k] = *(const u32x4*)(pr + PB + ch0);
    }
}
__device__ __forceinline__ void conv_finish2(const Params& p, int chunk, int k0, int tid, const ConvRows& R, const ConvW& W) {
    bf16_t* MIX = (bf16_t*)(p.ws + WS_MIX);
    const int ch0 = (tid & 63) * 8;
#pragma unroll
    for (int k = 0; k < 2; ++k) {
        const int t = chunk * 64 + (tid >> 6) + 8 * (k0 + k);
        float y[8]; float sq = 0.f;
#pragma unroll
        for (int e = 0; e < 4; ++e) {
            const float c0 = bf_lo(R.zm[k][e]) * W.w0[2 * e] + bf_lo(R.zc[k][e]) * W.w1[2 * e] + bf_lo(R.zp[k][e]) * W.w2[2 * e];
            const float c1 = bf_hi(R.zm[k][e]) * W.w0[2 * e + 1] + bf_hi(R.zc[k][e]) * W.w1[2 * e + 1] + bf_hi(R.zp[k][e]) * W.w2[2 * e + 1];
            y[2 * e] = bf_lo(R.bb[k][e]) * c0; y[2 * e + 1] = bf_hi(R.bb[k][e]) * c1;
            sq += y[2 * e] * y[2 * e] + y[2 * e + 1] * y[2 * e + 1];
        }
        sq += __shfl_xor(sq, 1); sq += __shfl_xor(sq, 2); sq += __shfl_xor(sq, 4);
        const float rn = rsqrtf(sq * (1.0f / 64.0f) + EPS);
        u32x4 o;
        o.x = cvt_pk_bf16(y[0] * rn * W.gn[0], y[1] * rn * W.gn[1]); o.y = cvt_pk_bf16(y[2] * rn * W.gn[2], y[3] * rn * W.gn[3]);
        o.z = cvt_pk_bf16(y[4] * rn * W.gn[4], y[5] * rn * W.gn[5]); o.w = cvt_pk_bf16(y[6] * rn * W.gn[6], y[7] * rn * W.gn[7]);
        *(u32x4*)(MIX + (size_t)t * DM + 512 + ch0) = o;
    }
}

__device__ __forceinline__ void p4_gla_phase(const Params& p, LAS unsigned char* lds) {
    const int tid = threadIdx.x, w = __builtin_amdgcn_readfirstlane(tid >> 6), lane = tid & 63, dir = w >> 2, dg = w & 3, fr = lane & 15, fq = lane >> 4;
    const int G = gridDim.x, NIT = NCHUNK * 4;
    int it = blockIdx.x;
    ConvW CW; conv_weights(p, tid, CW);
    int cs = 0; const int ncs = (blockIdx.x < NCHUNK) ? 8 * ((NCHUNK - 1 - (int)blockIdx.x) / G + 1) : 0;
    if (it < NIT) {
    GlaRaw raw; gla_raw_load<false>(p, it >> 2, it & 3, tid, raw);
    LAS bf16_t* KT = (LAS bf16_t*)(lds + L_QD); LAS bf16_t* VT = (LAS bf16_t*)(lds + L_VT);
    bf16_t* ST = (bf16_t*)(p.ws + WS_ST);
    for (; it < NIT; it += G) {
        const int chunk = it >> 2, h = it & 3;
        gla_raw_store<false>(lds, tid, raw);
        LDS_BARRIER();
        if (it + G < NIT) gla_raw_load<false>(p, (it + G) >> 2, (it + G) & 3, tid, raw);
        const bool cv = cs < ncs; ConvRows CR;
        if (cv) conv_load2(p, (int)blockIdx.x + (cs >> 3) * G, cs & 7, tid, CR);
        if (w < 4) gla_prep<0, 0>(p, lds, chunk, h, w, lane); else gla_prep<0, 1>(p, lds, chunk, h, w, lane);
        LDS_BARRIER();
        f32x4 acc[4][2];
#pragma unroll
        for (int mt = 0; mt < 4; ++mt)
#pragma unroll
            for (int nn = 0; nn < 2; ++nn) acc[mt][nn] = (f32x4){0.f, 0.f, 0.f, 0.f};
#pragma unroll
        for (int ks = 0; ks < 2; ++ks) {
            bf16x8 a[4], b[2];
#pragma unroll
            for (int mt = 0; mt < 4; ++mt) a[mt] = *(const LAS bf16x8*)(KT + (dir * 64 + mt * 16 + fr) * LD72 + ks * 32 + fq * 8);
#pragma unroll
            for (int nn = 0; nn < 2; ++nn) b[nn] = *(const LAS bf16x8*)(VT + ((dg * 2 + nn) * 16 + fr) * LD72 + ks * 32 + fq * 8);
#pragma unroll
            for (int mt = 0; mt < 4; ++mt)
#pragma unroll
                for (int nn = 0; nn < 2; ++nn) acc[mt][nn] = __builtin_amdgcn_mfma_f32_16x16x32_bf16(a[mt], b[nn], acc[mt][nn], 0, 0, 0);
        }
        bf16_t* sb = ST + ((size_t)(chunk * 4 + h) * 2 + dir) * 8192;
#pragma unroll
        for (int mt = 0; mt < 4; ++mt)
#pragma unroll
            for (int nn = 0; nn < 2; ++nn) {
                const int dv = (dg * 2 + nn) * 16 + fr, dk0 = mt * 16 + 4 * fq;
                u32x2 o; o.x = cvt_pk_bf16(acc[mt][nn][0], acc[mt][nn][1]); o.y = cvt_pk_bf16(acc[mt][nn][2], acc[mt][nn][3]);
                *(u32x2*)(sb + dv * 64 + dk0) = o;
            }
        if (cv) { conv_finish2(p, (int)blockIdx.x + (cs >> 3) * G, cs & 7, tid, CR, CW); cs += 2; }
    }
    }
    for (; cs < ncs; cs += 2) { ConvRows CR; conv_load2(p, (int)blockIdx.x + (cs >> 3) * G, cs & 7, tid, CR); conv_finish2(p, (int)blockIdx.x + (cs >> 3) * G, cs & 7, tid, CR, CW); }
}

__device__ __forceinline__ void p6_gla_phase(const Params& p, LAS unsigned char* lds) {
    const int tid = threadIdx.x, w = __builtin_amdgcn_readfirstlane(tid >> 6), lane = tid & 63, fr = lane & 15, fq = lane >> 4;
    const int G = gridDim.x, NIT = NCHUNK * 4;
    int it = blockIdx.x; if (it >= NIT) return;
    GlaRaw raw; gla_raw_load<true>(p, it >> 2, it & 3, tid, raw);
    LAS bf16_t* QD = (LAS bf16_t*)(lds + L_QD); LAS bf16_t* KI = (LAS bf16_t*)(lds + L_KI); LAS bf16_t* VT = (LAS bf16_t*)(lds + L_VT); LAS bf16_t* PP = (LAS bf16_t*)(lds + L_PP);
    LAS float* SSQ = (LAS float*)(lds + L_SSQ);
    const bf16_t* P = (const bf16_t*)(p.ws + WS_P);
    const bf16_t* ST = (const bf16_t*)(p.ws + WS_ST);
    bf16_t* MIX = (bf16_t*)(p.ws + WS_MIX);
    const int ti = w & 3, hf = w >> 2;
    for (; it < NIT; it += G) {
        const int chunk = it >> 2, h = it & 3;
        gla_raw_store<true>(lds, tid, raw);
        LDS_BARRIER();
        if (it + G < NIT) gla_raw_load<true>(p, (it + G) >> 2, (it + G) & 3, tid, raw);
        bf16x8 sfr[2][2];
#pragma unroll
        for (int d2 = 0; d2 < 2; ++d2) { const bf16_t* sbase = ST + ((size_t)(chunk * 4 + h) * 2 + d2) * 8192;
#pragma unroll
            for (int ks = 0; ks < 2; ++ks) sfr[d2][ks] = *(const bf16x8*)(sbase + (w * 16 + fr) * 64 + ks * 32 + fq * 8); }
        const int i = ti * 16 + fr;
        const int vcol = h * 128 + w * 16 + 4 * fq;
        u32x2 gv[4];
#pragma unroll
        for (int x = 0; x < 4; ++x) gv[x] = *(const u32x2*)(P + ((size_t)chunk * 64 + x * 16 + fr) * PLD + PG + vcol);
        const f32x4 hn = *(const f32x4*)(p.gla_norm + vcol);
        if (w < 4) gla_prep<1, 0>(p, lds, chunk, h, w, lane); else gla_prep<1, 1>(p, lds, chunk, h, w, lane);
        LDS_BARRIER();
#pragma unroll
        for (int jj = 0; jj < 2; ++jj) {
            const int jt = hf * 2 + jj;
            f32x4 sf = (f32x4){0.f, 0.f, 0.f, 0.f}, sb = (f32x4){0.f, 0.f, 0.f, 0.f};
#pragma unroll
            for (int ks = 0; ks < 2; ++ks) {
                const bf16x8 af = *(const LAS bf16x8*)(KI + (0 * 64 + jt * 16 + fr) * LD72 + ks * 32 + fq * 8);
                const bf16x8 bfw = *(const LAS bf16x8*)(QD + (0 * 64 + ti * 16 + fr) * LD72 + ks * 32 + fq * 8);
                sf = __builtin_amdgcn_mfma_f32_16x16x32_bf16(af, bfw, sf, 0, 0, 0);
                const bf16x8 ab = *(const LAS bf16x8*)(KI + (1 * 64 + jt * 16 + fr) * LD72 + ks * 32 + fq * 8);
                const bf16x8 bb = *(const LAS bf16x8*)(QD + (1 * 64 + ti * 16 + fr) * LD72 + ks * 32 + fq * 8);
                sb = __builtin_amdgcn_mfma_f32_16x16x32_bf16(ab, bb, sb, 0, 0, 0);
            }
            float pv[4];
#pragma unroll
            for (int e = 0; e < 4; ++e) { const int j = jt * 16 + 4 * fq + e; pv[e] = (j <= i ? sf[e] : 0.f) + (j >= i ? sb[e] : 0.f); }
            u32x2 o; o.x = cvt_pk_bf16(pv[0], pv[1]); o.y = cvt_pk_bf16(pv[2], pv[3]);
            *(LAS u32x2*)(PP + i * LD72 + jt * 16 + 4 * fq) = o;
        }
        LDS_BARRIER();
        f32x4 acc[4];
#pragma unroll
        for (int x = 0; x < 4; ++x) acc[x] = (f32x4){0.f, 0.f, 0.f, 0.f};
#pragma unroll
        for (int ks = 0; ks < 2; ++ks) {
            const bf16x8 a = *(const LAS bf16x8*)(VT + (w * 16 + fr) * LD72 + ks * 32 + fq * 8);
#pragma unroll
            for (int x = 0; x < 4; ++x) {
                const bf16x8 b = *(const LAS bf16x8*)(PP + (x * 16 + fr) * LD72 + ks * 32 + fq * 8);
                acc[x] = __builtin_amdgcn_mfma_f32_16x16x32_bf16(a, b, acc[x], 0, 0, 0);
            }
        }
#pragma unroll
        for (int d2 = 0; d2 < 2; ++d2)
#pragma unroll
            for (int ks = 0; ks < 2; ++ks) {
#pragma unroll
                for (int x = 0; x < 4; ++x) {
                    const bf16x8 b = *(const LAS bf16x8*)(QD + (d2 * 64 + x * 16 + fr) * LD72 + ks * 32 + fq * 8);
                    acc[x] = __builtin_amdgcn_mfma_f32_16x16x32_bf16(sfr[d2][ks], b, acc[x], 0, 0, 0);
                }
            }
#pragma unroll
        for (int x = 0; x < 4; ++x) {
            float sq = (acc[x][0] * acc[x][0] + acc[x][1] * acc[x][1]) + (acc[x][2] * acc[x][2] + acc[x][3] * acc[x][3]);
            sq += __shfl_xor(sq, 16); sq += __shfl_xor(sq, 32);
            if (fq == 0) SSQ[w * 64 + x * 16 + fr] = sq;
        }
        LDS_BARRIER();
#pragma unroll
        for (int x = 0; x < 4; ++x) {
            const int tk = x * 16 + fr; float tot = 0.f;
#pragma unroll
            for (int ww = 0; ww < 8; ++ww) tot += SSQ[ww * 64 + tk];
            const float rn = rsqrtf(tot * (1.0f / 128.0f) + EPS);
            const float o0 = acc[x][0] * rn * hn[0] * silu_f(bf_lo(gv[x].x)), o1 = acc[x][1] * rn * hn[1] * silu_f(bf_hi(gv[x].x));
            const float o2 = acc[x][2] * rn * hn[2] * silu_f(bf_lo(gv[x].y)), o3 = acc[x][3] * rn * hn[3] * silu_f(bf_hi(gv[x].y));
            u32x2 o; o.x = cvt_pk_bf16(o0, o1); o.y = cvt_pk_bf16(o2, o3);
            *(u32x2*)(MIX + ((size_t)chunk * 64 + tk) * DM + vcol) = o;
        }
    }
}

template <int EPT, int UB> struct ScanBatch { u32x4 x8[EPT == 8 ? UB : 1]; f32x4 da[EPT == 8 ? UB : 1], db[EPT == 8 ? UB : 1]; bf16_t x1[EPT == 1 ? UB : 1]; float d1[EPT == 1 ? UB : 1]; };
template <int EPT, int UB> __device__ __forceinline__ void scan_load(ScanBatch<EPT, UB>& B, const bf16_t* sp, const float* dp, long cs, long ds, int n0) {
#pragma unroll
    for (int i = 0; i < UB; ++i) {
        if constexpr (EPT == 1) { B.x1[i] = sp[cs * (n0 + i)]; B.d1[i] = dp[ds * (n0 + i)]; }
        else { B.x8[i] = *(const u32x4*)(sp + cs * (n0 + i)); B.da[i] = *(const f32x4*)(dp + ds * (n0 + i)); B.db[i] = *(const f32x4*)(dp + ds * (n0 + i) + 4); }
    }
}
template <int EPT, int UB> __device__ __forceinline__ void scan_step(const ScanBatch<EPT, UB>& B, float (&S)[EPT], bf16_t* sp, long cs, int n0) {
#pragma unroll
    for (int i = 0; i < UB; ++i) {
        if constexpr (EPT == 1) { sp[cs * (n0 + i)] = (bf16_t)(cvt_pk_bf16(S[0], 0.f) & 0xffffu); S[0] = B.d1[i] * S[0] + __uint_as_float(((unsigned)B.x1[i]) << 16); }
        else {
            u32x4 o; o.x = cvt_pk_bf16(S[0], S[1]); o.y = cvt_pk_bf16(S[2], S[3]); o.z = cvt_pk_bf16(S[4], S[5]); o.w = cvt_pk_bf16(S[6], S[7]);
            *(u32x4*)(sp + cs * (n0 + i)) = o;
            S[0] = B.da[i][0] * S[0] + bf_lo(B.x8[i].x); S[1] = B.da[i][1] * S[1] + bf_hi(B.x8[i].x); S[2] = B.da[i][2] * S[2] + bf_lo(B.x8[i].y); S[3] = B.da[i][3] * S[3] + bf_hi(B.x8[i].y);
            S[4] = B.db[i][0] * S[4] + bf_lo(B.x8[i].z); S[5] = B.db[i][1] * S[5] + bf_hi(B.x8[i].z); S[6] = B.db[i][2] * S[6] + bf_lo(B.x8[i].w); S[7] = B.db[i][3] * S[7] + bf_hi(B.x8[i].w);
        }
    }
}
template <int EPT, int UB>
__device__ __forceinline__ void p5_scan(bf16_t* ST, const float* DEC, int head, int dir, int c_first, int nchunks, int e0) {
    const long sgn = dir ? -1 : 1; const long cs = sgn * (4 * 2 * 8192), ds = sgn * (4 * 2 * 64);
    const int c0 = dir ? c_first + nchunks - 1 : c_first;
    bf16_t* sp = ST + ((size_t)(c0 * 4 + head) * 2 + dir) * 8192 + e0;
    const float* dp = DEC + ((size_t)(c0 * 4 + head) * 2 + dir) * 64 + (e0 & 63);
    float S[EPT];
#pragma unroll
    for (int e = 0; e < EPT; ++e) S[e] = 0.f;
    ScanBatch<EPT, UB> A, B;
    scan_load<EPT, UB>(A, sp, dp, cs, ds, 0);
    for (int n0 = 0; n0 < nchunks; n0 += 2 * UB) {
        scan_load<EPT, UB>(B, sp, dp, cs, ds, n0 + UB);
        scan_step<EPT, UB>(A, S, sp, cs, n0);
        if (n0 + 2 * UB < nchunks) scan_load<EPT, UB>(A, sp, dp, cs, ds, n0 + 2 * UB);
        scan_step<EPT, UB>(B, S, sp, cs, n0 + UB);
    }
}

#define XB_TMO      128
#define XB_XCNT(j)  (256  + 64 * (j))
#define XB_XSUB(j)  (1280 + 64 * (j))
#define XB_XGEN(j)  (2304 + 64 * (j))
#define XB_TOP      3328
#define XB_TOPGEN   3392
#define XCD_BAR_WORDS 3456
#define XB_SPIN_CAP (1u << 18)
__device__ __forceinline__ unsigned xb_ld(unsigned* p)              { return __hip_atomic_load(p, __ATOMIC_RELAXED, __HIP_MEMORY_SCOPE_AGENT); }
__device__ __forceinline__ unsigned xb_add(unsigned* p, unsigned v) { return __hip_atomic_fetch_add(p, v, __ATOMIC_RELAXED, __HIP_MEMORY_SCOPE_AGENT); }
__device__ __forceinline__ unsigned xb_xcc_id() { return (unsigned)__builtin_amdgcn_s_getreg((3 << 11) | 20) & 0xFu; }
#define XB_SPIN(cond, bar) do { unsigned _sp = 0; while (cond) { __builtin_amdgcn_s_sleep(1); \
    if ((++_sp & 255u) == 0u) { if (xb_ld(&(bar)[XB_TMO])) break; if (_sp > XB_SPIN_CAP) { atomicAdd(&(bar)[XB_TMO], 1u); break; } } } } while (0)
struct XcdBarrier { unsigned* bar; unsigned x; volatile LAS unsigned* st; };
__device__ __forceinline__ XcdBarrier xcd_barrier_post(unsigned* bar, volatile LAS unsigned* st) {
    XcdBarrier b; b.bar = bar; b.x = xb_xcc_id(); b.st = st;
    if (threadIdx.x == 0) (void)xb_add(&bar[XB_XCNT(b.x)], 1u);
    return b;
}
__device__ __forceinline__ void xcd_barrier_complete(unsigned* bar, unsigned x, unsigned& nloc, unsigned& nx) {
    const unsigned G = gridDim.x * gridDim.y * gridDim.z;
    unsigned sum, cnt, mine, sp = 0u;
    for (;;) {
        sum = 0u; cnt = 0u; mine = 0u;
#pragma unroll
        for (unsigned j = 0; j < 16; ++j) { const unsigned c = xb_ld(&bar[XB_XCNT(j)]); sum += c; cnt += (c > 0u) ? 1u : 0u; mine = (j == x) ? c : mine; }
        if (sum == G) break;
        __builtin_amdgcn_s_sleep(1);
        if ((++sp & 255u) == 0u) { if (xb_ld(&bar[XB_TMO])) break; if (sp > XB_SPIN_CAP) { atomicAdd(&bar[XB_TMO], 1u); break; } }
    }
    nloc = mine > 0u ? mine : 1u; nx = cnt > 0u ? cnt : 1u;
}
__device__ __forceinline__ void xcd_barrier(const XcdBarrier& b) {
    asm volatile("s_waitcnt vmcnt(0)" ::: "memory");
    __syncthreads();
    if (threadIdx.x == 0) {
        unsigned* bar = b.bar;
        __builtin_amdgcn_s_waitcnt(0);
        unsigned nloc = b.st[0], nx = b.st[1];
        if (nloc == 0u) { xcd_barrier_complete(bar, b.x, nloc, nx); b.st[0] = nloc; b.st[1] = nx; }
        const unsigned old = xb_add(&bar[XB_XSUB(b.x)], 1u);
        const unsigned gen = old / nloc;
        if (old + 1u == (gen + 1u) * nloc) {
            __builtin_amdgcn_fence(__ATOMIC_RELEASE, "agent");
            asm volatile("s_waitcnt vmcnt(0)" ::: "memory");
            const unsigned og = xb_add(&bar[XB_TOP], 1u);
            const unsigned tg = og / nx;
            if (og + 1u == (tg + 1u) * nx) xb_add(&bar[XB_TOPGEN], 1u);
            else XB_SPIN(xb_ld(&bar[XB_TOPGEN]) == tg, bar);
            __builtin_amdgcn_fence(__ATOMIC_ACQUIRE, "agent");
            xb_add(&bar[XB_XGEN(b.x)], 1u);
            asm volatile("s_waitcnt vmcnt(0)" ::: "memory");
        } else {
            XB_SPIN(xb_ld(&bar[XB_XGEN(b.x)]) == gen, bar);
            __builtin_amdgcn_fence(__ATOMIC_ACQUIRE, "agent");
            asm volatile("s_waitcnt vmcnt(0)" ::: "memory");
        }
    }
    __syncthreads();
}

constexpr int LDS_BYTES = 147456;
__global__ void __launch_bounds__(512, 2) fwd_megakernel(Params p) {
    extern __shared__ __attribute__((aligned(16))) unsigned char lds_raw[];
    LAS unsigned char* lds = (LAS unsigned char*)lds_raw;
    cg::grid_group grid = cg::this_grid();
    unsigned char* ws = p.ws;
    const int G = gridDim.x, bid = blockIdx.x;
    float* SS = (float*)(ws + WS_SS);
    bf16_t* XB = (bf16_t*)(ws + WS_XB);
    bf16_t* HB = (bf16_t*)(ws + WS_H);
    bf16_t* MIX = (bf16_t*)(ws + WS_MIX);
    const int lo = p.ph_lo, hi = p.ph_hi;
    volatile LAS unsigned* bst = (volatile LAS unsigned*)(lds + LDS_BYTES - 64);
    if (threadIdx.x == 0) { bst[0] = 0u; bst[1] = 0u; }
    __syncthreads();
    if (hi == 0x7fffffff) grid.sync();
    XcdBarrier xbar; xbar.bar = (unsigned*)(ws + WS_BAR); xbar.x = 0; xbar.st = bst;
    if (hi - lo > 1) xbar = xcd_barrier_post((unsigned*)(ws + WS_BAR), bst);
#define IN(k) (lo <= (k) && (k) < hi)
#define SEAM(k) do { if (IN(k) && IN((k) + 1)) xcd_barrier(xbar); } while (0)

    if (IN(0)) p0_prologue(p, lds);
    SEAM(0);
    if (IN(1)) {
        pg8::Gemm g{XB, (const bf16_t*)(ws + WS_WGU1), T_TOK, 2 * DFF, DM}; pg8::StaticOrder S; S.init(T_TOK, 2 * DFF, G, bid);
        panel_prefill(lds + 131072 + 8192, SS, S);
        pg8::EpiSwiglu E{HB, SS, lds + 131072 + 8192};
        pg8::gemm_phase<pg8::EpiSwiglu, pg8::StaticOrder, true, true>(lds, g, S, E);
    }
    SEAM(1);
    if (IN(2)) {
        pg8::Gemm g{HB, (const bf16_t*)(ws + WS_WD1), T_TOK, DM, DFF}; pg8::StaticOrder S; S.init(T_TOK, DM, G, bid);
        pg8::EpiResid<false> E{nullptr, nullptr, XB, SS + (size_t)16 * T_TOK, 0.5f};
        pg8::gemm_phase<pg8::EpiResid<false>, pg8::StaticOrder, true, true>(lds, g, S, E);
    }
    SEAM(2);
    if (IN(3)) {
        pg8::Gemm g{XB, (const bf16_t*)(ws + WS_WIN), T_TOK, NIN_PAD, DM}; pg8::StaticOrder S; S.init(T_TOK, NIN_PAD, G, bid);
        panel_prefill(lds + 131072 + 8192, SS + (size_t)16 * T_TOK, S);
        pg8::EpiIn E{(bf16_t*)(ws + WS_P), (float*)(ws + WS_R), SS + (size_t)16 * T_TOK, lds + 131072 + 8192};
        pg8::gemm_phase<pg8::EpiIn, pg8::StaticOrder, true, true>(lds, g, S, E);
    }
    SEAM(3);
    if (IN(4)) {
        p4_gla_phase(p, lds);
    }
    SEAM(4);
    if (IN(5)) {
        bf16_t* ST = (bf16_t*)(ws + WS_ST); const float* DEC = (const float*)(ws + WS_DEC);
        for (int task = bid; task < 256; task += G) {
            if (task < 128) { const int chain = task >> 4, slice = task & 15; p5_scan<1, 16>(ST, DEC, chain >> 1, chain & 1, 0, 256, slice * 512 + (int)threadIdx.x); }
            else { const int idx = task - 128, chain = idx >> 1, half = idx & 1, seq = chain >> 3; p5_scan<8, 4>(ST, DEC, (chain & 7) >> 1, chain & 1, 256 + seq * 32, 32, (half * 512 + (int)threadIdx.x) * 8); }
        }
    }
    SEAM(5);
    if (IN(6)) {
        p6_gla_phase(p, lds);
    }
    SEAM(6);
    if (IN(7)) {
        pg8::Gemm g{MIX, (const bf16_t*)(ws + WS_WOUT), T_TOK, DM, DM}; pg8::StaticOrder S; S.init(T_TOK, DM, G, bid);
        pg8::EpiResid<false> E{nullptr, nullptr, XB, SS + (size_t)32 * T_TOK, 1.0f};
        pg8::gemm_phase<pg8::EpiResid<false>, pg8::StaticOrder, true, true>(lds, g, S, E);
    }
    SEAM(7);
    if (IN(8)) {
        pg8::Gemm g{XB, (const bf16_t*)(ws + WS_WGU2), T_TOK, 2 * DFF, DM}; pg8::StaticOrder S; S.init(T_TOK, 2 * DFF, G, bid);
        panel_prefill(lds + 131072 + 8192, SS + (size_t)32 * T_TOK, S);
        pg8::EpiSwiglu E{HB, SS + (size_t)32 * T_TOK, lds + 131072 + 8192};
        pg8::gemm_phase<pg8::EpiSwiglu, pg8::StaticOrder, true, true>(lds, g, S, E);
    }
    SEAM(8);
    if (IN(9)) {
        pg8::Gemm g{HB, (const bf16_t*)(ws + WS_WD2), T_TOK, DM, DFF}; pg8::StaticOrder S; S.init(T_TOK, DM, G, bid);
        pg8::EpiFinal E{XB, p.out, p.final_norm, SS + (size_t)48 * T_TOK, (unsigned*)(ws + WS_BAR) + 3584, 0.5f, lds + 131072};
        pg8::gemm_phase<pg8::EpiFinal, pg8::StaticOrder, true, true>(lds, g, S, E);
    }
#undef IN
#undef SEAM
}

#ifndef PHASE_MASK
#define PHASE_MASK 0x7FF
#endif
#ifndef N_LAUNCH_MODE
#define N_LAUNCH_MODE 1
#endif
extern "C" void kernel_launch(void* const* d_in, const int* in_sizes, int n_in, void* d_out, int out_size, void* d_ws, size_t ws_size, hipStream_t stream) {
    static int grid = 0;
    if (grid == 0) {
        int dev = 0, cus = 0, per_cu = 0;
        if (hipGetDevice(&dev) != hipSuccess || hipDeviceGetAttribute(&cus, hipDeviceAttributeMultiprocessorCount, dev) != hipSuccess) { fprintf(stderr, "device query failed\n"); grid = -1; return; }
        if (hipFuncSetAttribute((const void*)fwd_megakernel, hipFuncAttributeMaxDynamicSharedMemorySize, LDS_BYTES) != hipSuccess) { fprintf(stderr, "hipFuncSetAttribute failed\n"); grid = -1; return; }
        if (hipOccupancyMaxActiveBlocksPerMultiprocessor(&per_cu, (const void*)fwd_megakernel, 512, LDS_BYTES) != hipSuccess || per_cu < 1) { fprintf(stderr, "occupancy query: %d\n", per_cu); per_cu = 1; }
        (void)hipGetLastError();
        grid = cus * per_cu;
        if (n_in != 21 || ws_size < WS_END) { fprintf(stderr, "unexpected n_in %d / ws %zu (need %zu)\n", n_in, ws_size, (size_t)WS_END); grid = -1; return; }
    }
    if (grid < 0) return;
    Params p{};
    const float** pp = (const float**)&p;
    for (int i = 0; i < 21; ++i) pp[i] = (const float*)d_in[i];
    p.out = (float*)d_out; p.ws = (unsigned char*)d_ws;
    if (hipMemsetAsync((char*)d_ws + WS_BAR, 0, 16384, stream) != hipSuccess) { fprintf(stderr, "memset of barrier words failed\n"); return; }
#if N_LAUNCH_MODE == 1
    p.ph_lo = 0; p.ph_hi = 11;
    void* args[] = {&p};
    hipError_t e = hipLaunchCooperativeKernel((const void*)fwd_megakernel, dim3(grid), dim3(512), args, LDS_BYTES, stream);
    if (e != hipSuccess) fprintf(stderr, "cooperative launch failed: %s (grid %d)\n", hipGetErrorString(e), grid);
#else
    for (int k = 0; k < 11; ++k) { if (!((PHASE_MASK >> k) & 1)) continue; p.ph_lo = k; p.ph_hi = k + 1; hipLaunchKernelGGL(fwd_megakernel, dim3(grid), dim3(512), LDS_BYTES, stream, p); }
#endif
}
```

```cpp
#include <hip/hip_runtime.h>
#include <hip/hip_cooperative_groups.h>
#include <cstdio>
#include <cstdint>
namespace cg = cooperative_groups;

#define LAS __attribute__((address_space(3)))
typedef unsigned short bf16_t;
typedef short bf16x8 __attribute__((ext_vector_type(8)));
typedef float f32x4 __attribute__((ext_vector_type(4)));
typedef unsigned u32x4 __attribute__((ext_vector_type(4)));
typedef unsigned u32x2 __attribute__((ext_vector_type(2)));

constexpr int T_TOK = 32768, T_PROMPT = 16384, SAMPLE_LEN = 2048, DM = 1024, DFF = 2816, NIN_PAD = 3328;
constexpr int PLD = 2560;
constexpr int PQ = 0, PK = 256, PV = 512, PG = 1024, PZ = 1536, PB = 2048;
constexpr int NCHUNK = 512;
constexpr float EPS = 1e-6f;
constexpr size_t WS_WGU1 = 0;
constexpr size_t WS_WD1 = WS_WGU1 + (size_t)2 * DFF * DM * 2;
constexpr size_t WS_WIN = WS_WD1 + (size_t)DM * DFF * 2;
constexpr size_t WS_WOUT = WS_WIN + (size_t)NIN_PAD * DM * 2;
constexpr size_t WS_WGU2 = WS_WOUT + (size_t)DM * DM * 2;
constexpr size_t WS_WD2 = WS_WGU2 + (size_t)2 * DFF * DM * 2;
constexpr size_t WS_SS = WS_WD2 + (size_t)DM * DFF * 2;
constexpr size_t WS_DEC = WS_SS + (size_t)4 * T_TOK * 16 * 4;
constexpr size_t WS_R = WS_DEC + (size_t)NCHUNK * 4 * 2 * 64 * 4;
constexpr size_t WS_XB = WS_R + (size_t)T_TOK * 32 * 4;
constexpr size_t WS_H = WS_XB + (size_t)T_TOK * DM * 2;
constexpr size_t WS_P = WS_H + (size_t)T_TOK * DFF * 2;
constexpr size_t WS_BAR = WS_P + (size_t)T_TOK * PLD * 2;
constexpr size_t WS_END = WS_BAR + 16384;
constexpr size_t WS_MIX = WS_H;
constexpr size_t WS_ST = WS_H + (size_t)T_TOK * DM * 2;
static_assert(WS_ST + (size_t)NCHUNK * 4 * 2 * 8192 * 2 <= WS_P, "overlay");

struct Params {
    const float *x_prompt, *x_sample, *ffn1_norm, *ffn1_wg, *ffn1_wu, *ffn1_wd, *mix_norm, *w_in, *gfw, *gfb, *gbw, *gbb, *gla_norm, *conv_w, *conv_norm, *w_out,
        *ffn2_norm, *ffn2_wg, *ffn2_wu, *ffn2_wd, *final_norm;
    float* out; unsigned char* ws;
    int ph_lo, ph_hi;
};

typedef float f32x2_t __attribute__((ext_vector_type(2)));
typedef __bf16 bf16x2_t __attribute__((ext_vector_type(2)));
__device__ __forceinline__ unsigned cvt_pk_bf16(float lo, float hi) { const f32x2_t v = {lo, hi}; const bf16x2_t b = __builtin_convertvector(v, bf16x2_t); return __builtin_bit_cast(unsigned, b); }
__device__ __forceinline__ float bf_lo(unsigned u) { return __uint_as_float(u << 16); }
__device__ __forceinline__ float bf_hi(unsigned u) { return __uint_as_float(u & 0xffff0000u); }
__device__ __forceinline__ float silu_f(float g) { return g * __builtin_amdgcn_rcpf(1.0f + __expf(-g)); }

__device__ __forceinline__ float row_ss(const float* ssp, int row) {
    const f32x4 a = *(const f32x4*)(ssp + (size_t)row * 16), b = *(const f32x4*)(ssp + (size_t)row * 16 + 4), c = *(const f32x4*)(ssp + (size_t)row * 16 + 8), d = *(const f32x4*)(ssp + (size_t)row * 16 + 12);
    return ((a[0] + a[1]) + (a[2] + a[3])) + ((b[0] + b[1]) + (b[2] + b[3])) + ((c[0] + c[1]) + (c[2] + c[3])) + ((d[0] + d[1]) + (d[2] + d[3]));
}

__device__ __forceinline__ const LAS float* panel_scales(LAS unsigned char* xl, const float* ss, int pm) {
    LAS float* RSL = (LAS float*)xl; LAS int* tag = (LAS int*)(xl + 1024);
    if (*tag != pm) {
        const int tid = threadIdx.x;
        if (tid < 256) RSL[tid] = rsqrtf(row_ss(ss, pm * 256 + tid) * (1.0f / DM) + EPS);
        asm volatile("s_waitcnt lgkmcnt(0)" ::: "memory"); __builtin_amdgcn_s_barrier(); asm volatile("" ::: "memory");
        if (tid == 0) *tag = pm;
        asm volatile("s_waitcnt lgkmcnt(0)" ::: "memory"); __builtin_amdgcn_s_barrier(); asm volatile("" ::: "memory");
    }
    return RSL;
}

namespace pg8 {
constexpr int BM = 256, BK = 64, HALF = 128, HTB = HALF * BK * 2, STAGE_BYTES = 8 * HTB, NXCD = 8, WGM = 8;
__host__ __device__ __forceinline__ int lds_byte(int r, int c) { const int st = (r >> 4) * 2 + (c >> 5), rr = r & 15, cc = c & 31, ob = rr * 64 + cc * 2; return st * 1024 + (ob ^ (((ob >> 9) & 1) << 5)); }
__host__ __device__ __forceinline__ void stage_rc(int b, int& R, int& C) { const int st = b / 1024, sb = b % 1024, swz = sb ^ (((sb >> 9) & 1) << 5); R = (st >> 1) * 16 + swz / 64; C = (st & 1) * 32 + (swz % 64) / 2; }
__host__ __device__ __forceinline__ int perm32(int rho) { const int n = rho >> 4, i = rho & 15; return 8 * (i >> 2) + 4 * n + (i & 3); }
struct Unit { int pm, pn; };
struct Gemm { const bf16_t* A; const bf16_t* Bt; int M, N, K; };
struct StaticOrder {
    int nM, nN, nwg, G, c;
    __host__ __device__ void init(int M, int N, int G_, int c_) { nM = M / BM; nN = N / BM; nwg = nM * nN; G = G_; c = c_; }
    __host__ __device__ bool next(int i, Unit& u) const {
        const long L = (long)i * G + c; if (L >= nwg) return false;
        int wgid = (int)L; { const int q = nwg / NXCD, r = nwg % NXCD, xcd = wgid % NXCD, off = wgid / NXCD; wgid = (xcd < r ? xcd * (q + 1) : r * (q + 1) + (xcd - r) * q) + off; }
        const int nig = WGM * nN, gid = wgid / nig, fm = gid * WGM, gsz = (nM - fm) < WGM ? (nM - fm) : WGM;
        u.pm = fm + ((wgid % nig) % gsz); u.pn = (wgid % nig) / gsz; return true;
    }
    __device__ __forceinline__ void a_ready(const Unit&) const {}
    __device__ __forceinline__ void done(const Unit&) const {}
};

template <class Epi, class Sched, bool ALIGN_EPI = false, bool SP2 = false>
__device__ __forceinline__ void gemm_phase(LAS unsigned char* lds, const Gemm g, const Sched& S, const Epi& E) {
    const int tid = threadIdx.x, wid = __builtin_amdgcn_readfirstlane(tid >> 6), lane = tid & 63, wr = wid >> 2, wc = wid & 3, fr = lane & 15, fq = lane >> 4;
    const int K = g.K, nt = K / BK;
    unsigned voffA[2], voffB[2];
#pragma unroll
    for (int i = 0; i < 2; ++i) { int R, C; stage_rc(tid * 16 + i * 8192, R, C); const int Rb = Epi::PERM ? ((R & ~31) + perm32(R & 31)) : R;
        voffA[i] = (unsigned)(R * K + C) * 2u; voffB[i] = (unsigned)(Rb * K + C) * 2u; }
    const size_t kstep = (size_t)(BK * 2);
    const size_t hstep = (size_t)HALF * K * 2;
    const size_t tstep = 2 * hstep;
    const unsigned ldsw = (unsigned)wid * 1024u;
    const int aoff = lds_byte(wr * 64 + fr, fq * 8), boff = lds_byte(wc * 32 + fr, fq * 8);
#define PG8_SA(b, h) (((b) * 2 + (h)) * HTB)
#define PG8_SB(b, h) ((4 + (b) * 2 + (h)) * HTB)
#define PG8_STAGE(bufoff, gbase, voff) do { _Pragma("unroll") for (int _i = 0; _i < 2; ++_i) \
        __builtin_amdgcn_global_load_lds((const unsigned*)((const char*)(gbase) + (voff)[_i]), (LAS unsigned*)(lds + (bufoff) + ldsw + _i * 8192), 16, 0, 0); } while (0)
#define PG8_LDA(dst, b, h) do { _Pragma("unroll") for (int m = 0; m < 4; ++m) _Pragma("unroll") for (int k = 0; k < 2; ++k) dst[m][k] = *(const LAS bf16x8*)(lds + PG8_SA(b, h) + aoff + m * 2048 + k * 1024); } while (0)
#define PG8_LDB(dst, b, h) do { _Pragma("unroll") for (int n = 0; n < 2; ++n) _Pragma("unroll") for (int k = 0; k < 2; ++k) dst[n][k] = *(const LAS bf16x8*)(lds + PG8_SB(b, h) + boff + n * 2048 + k * 1024); } while (0)
#define PG8_MMA(ai, bj, At, Bt) do { __builtin_amdgcn_s_setprio(1); _Pragma("unroll") for (int m = 0; m < 4; ++m) _Pragma("unroll") for (int n = 0; n < 2; ++n) _Pragma("unroll") for (int k = 0; k < 2; ++k) \
        acc[ai][bj][m][n] = __builtin_amdgcn_mfma_f32_16x16x32_bf16(Bt[n][k], At[m][k], acc[ai][bj][m][n], 0, 0, 0); __builtin_amdgcn_s_setprio(0); } while (0)
#define PG8_WAIT_V(n) asm volatile("s_waitcnt vmcnt(" #n ")" ::: "memory")
#define PG8_WAIT_L(n) asm volatile("s_waitcnt lgkmcnt(" #n ")" ::: "memory")
#define PG8_BAR __builtin_amdgcn_s_barrier()
#define PG8_SCHED __builtin_amdgcn_sched_barrier(0)
    Unit cur, nxt; int ui = 0;
    if (!S.next(0, cur)) return;
    if constexpr (Epi::STAGGER) { const int slot = (blockIdx.x >> 3) & 7; for (int i = 0; i < slot; ++i) __builtin_amdgcn_s_sleep(32); }
    f32x4 acc[2][2][4][2];
#pragma unroll
    for (int a = 0; a < 2; ++a)
#pragma unroll
        for (int b = 0; b < 2; ++b)
#pragma unroll
            for (int m = 0; m < 4; ++m)
#pragma unroll
                for (int n = 0; n < 2; ++n) acc[a][b][m][n] = (f32x4){0.f, 0.f, 0.f, 0.f};
    bf16x8 At[4][2], B0[2][2], B1[2][2];
    const char* cA = (const char*)g.A + (size_t)cur.pm * tstep; const char* cB = (const char*)g.Bt + (size_t)cur.pn * tstep;
    S.a_ready(cur);
    if constexpr (SP2) {
        PG8_STAGE(PG8_SB(0, 0), cB, voffB); PG8_STAGE(PG8_SB(0, 1), cB + hstep, voffB); PG8_STAGE(PG8_SA(0, 0), cA, voffA); PG8_STAGE(PG8_SA(0, 1), cA + hstep, voffA);
        if (wr == 1) PG8_BAR;
        PG8_WAIT_V(2); PG8_BAR;
        PG8_STAGE(PG8_SB(1, 0), cB + kstep, voffB); PG8_STAGE(PG8_SA(1, 0), cA + kstep, voffA); PG8_STAGE(PG8_SB(1, 1), cB + hstep + kstep, voffB);
        PG8_WAIT_V(6); PG8_BAR;
    } else {
        PG8_STAGE(PG8_SB(0, 0), cB, voffB); PG8_STAGE(PG8_SA(0, 0), cA, voffA); PG8_STAGE(PG8_SB(0, 1), cB + hstep, voffB); PG8_STAGE(PG8_SA(0, 1), cA + hstep, voffA);
        if (wr == 1) PG8_BAR;
        PG8_WAIT_V(4); PG8_BAR;
        PG8_STAGE(PG8_SB(1, 0), cB + kstep, voffB); PG8_STAGE(PG8_SA(1, 0), cA + kstep, voffA); PG8_STAGE(PG8_SB(1, 1), cB + hstep + kstep, voffB);
        PG8_WAIT_V(6); PG8_BAR;
    }
    for (;;) {
        const bool has_next = S.next(ui + 1, nxt);
        const char* nA = has_next ? (const char*)g.A + (size_t)nxt.pm * tstep : cA; const char* nB = has_next ? (const char*)g.Bt + (size_t)nxt.pn * tstep : cB;
        for (int t = 0; t < nt; t += 2) {
            const bool last = (t == nt - 2);
            const char* a1 = cA + (size_t)(t + 1) * kstep;
            const char* a2 = last ? nA : cA + (size_t)(t + 2) * kstep; const char* b2 = last ? nB : cB + (size_t)(t + 2) * kstep;
            const char* a3 = a2 + kstep; const char* b3 = b2 + kstep;
            if (last && has_next) S.a_ready(nxt);
            if constexpr (SP2) {
            PG8_LDB(B0, 0, 0); PG8_LDB(B1, 0, 1); PG8_SCHED; PG8_LDA(At, 0, 0); PG8_STAGE(PG8_SA(1, 1), a1 + hstep, voffA);
            PG8_WAIT_V(8); PG8_WAIT_L(0); PG8_BAR; PG8_MMA(0, 0, At, B0); PG8_MMA(0, 1, At, B1); PG8_BAR; PG8_SCHED;
            PG8_LDA(At, 0, 1); PG8_STAGE(PG8_SB(0, 0), b2, voffB); PG8_STAGE(PG8_SB(0, 1), b2 + hstep, voffB); PG8_STAGE(PG8_SA(0, 0), a2, voffA);
            PG8_WAIT_V(8); PG8_WAIT_L(0); PG8_BAR; PG8_MMA(1, 0, At, B0); PG8_MMA(1, 1, At, B1); PG8_BAR; PG8_SCHED;
            PG8_LDB(B0, 1, 0); PG8_LDB(B1, 1, 1); PG8_SCHED; PG8_LDA(At, 1, 0); PG8_STAGE(PG8_SA(0, 1), a2 + hstep, voffA);
            PG8_WAIT_V(8); PG8_WAIT_L(0); PG8_BAR; PG8_MMA(0, 0, At, B0); PG8_MMA(0, 1, At, B1); PG8_BAR; PG8_SCHED;
            PG8_LDA(At, 1, 1); PG8_STAGE(PG8_SB(1, 0), b3, voffB); PG8_STAGE(PG8_SB(1, 1), b3 + hstep, voffB); PG8_STAGE(PG8_SA(1, 0), a3, voffA);
            PG8_WAIT_V(8); PG8_WAIT_L(0); PG8_BAR; PG8_MMA(1, 0, At, B0); PG8_MMA(1, 1, At, B1); PG8_BAR; PG8_SCHED;
            } else {
            PG8_LDB(B0, 0, 0); PG8_SCHED; PG8_LDA(At, 0, 0); PG8_STAGE(PG8_SA(1, 1), a1 + hstep, voffA);
            PG8_WAIT_L(8); PG8_BAR; PG8_WAIT_L(0); PG8_MMA(0, 0, At, B0); PG8_BAR; PG8_SCHED;
            PG8_LDB(B1, 0, 1); PG8_STAGE(PG8_SB(0, 0), b2, voffB);
            PG8_BAR; PG8_WAIT_L(0); PG8_MMA(0, 1, At, B1); PG8_BAR;
            PG8_LDA(At, 0, 1); PG8_STAGE(PG8_SA(0, 0), a2, voffA);
            PG8_BAR; PG8_WAIT_L(0); PG8_MMA(1, 0, At, B0); PG8_BAR; PG8_SCHED;
            PG8_STAGE(PG8_SB(0, 1), b2 + hstep, voffB);
            PG8_WAIT_V(6); PG8_BAR; PG8_MMA(1, 1, At, B1); PG8_BAR;
            PG8_LDB(B0, 1, 0); PG8_SCHED; PG8_LDA(At, 1, 0); PG8_STAGE(PG8_SA(0, 1), a2 + hstep, voffA);
            PG8_WAIT_L(8); PG8_BAR; PG8_WAIT_L(0); PG8_MMA(0, 0, At, B0); PG8_BAR; PG8_SCHED;
            PG8_LDB(B1, 1, 1); PG8_STAGE(PG8_SB(1, 0), b3, voffB);
            PG8_BAR; PG8_WAIT_L(0); PG8_MMA(0, 1, At, B1); PG8_BAR;
            PG8_LDA(At, 1, 1); PG8_STAGE(PG8_SA(1, 0), a3, voffA);
            PG8_BAR; PG8_WAIT_L(0); PG8_MMA(1, 0, At, B0); PG8_BAR; PG8_SCHED;
            PG8_STAGE(PG8_SB(1, 1), b3 + hstep, voffB);
            PG8_WAIT_V(6); PG8_BAR; PG8_MMA(1, 1, At, B1); PG8_BAR;
            }
        }
        if constexpr (ALIGN_EPI) { if (wr == 0) PG8_BAR; }
        E(acc, cur, wr, wc, fr, fq);
        if (!has_next) break;
#pragma unroll
        for (int a = 0; a < 2; ++a)
#pragma unroll
            for (int b = 0; b < 2; ++b)
#pragma unroll
                for (int m = 0; m < 4; ++m)
#pragma unroll
                    for (int n = 0; n < 2; ++n) acc[a][b][m][n] = (f32x4){0.f, 0.f, 0.f, 0.f};
        cur = nxt; cA = nA; cB = nB; ++ui;
        if constexpr (ALIGN_EPI) { if (wr == 1) PG8_BAR; }
    }
    PG8_WAIT_V(0);
    if constexpr (!ALIGN_EPI) { if (wr == 0) PG8_BAR; }
    PG8_BAR;
#undef PG8_SA
#undef PG8_SB
#undef PG8_STAGE
#undef PG8_LDA
#undef PG8_LDB
#undef PG8_MMA
#undef PG8_WAIT_V
#undef PG8_WAIT_L
#undef PG8_BAR
#undef PG8_SCHED
}

struct EpiSwiglu {
    static constexpr bool PERM = true, STAGGER = false;
    bf16_t* H; const float* ss; LAS unsigned char* xl;
    __device__ __forceinline__ void operator()(const f32x4 (&acc)[2][2][4][2], const Unit& u, int wr, int wc, int fr, int fq) const {
        const int row0 = u.pm * BM + wr * 64 + fr, col0 = u.pn * 128 + wc * 32 + 8 * fq;
        const LAS float* RSL = panel_scales(xl, ss, u.pm);
#pragma unroll
        for (int ai = 0; ai < 2; ++ai)
#pragma unroll
            for (int m = 0; m < 4; ++m) {
                const int row = row0 + ai * HALF + m * 16;
                const float rs = RSL[wr * 64 + fr + ai * HALF + m * 16];
                const float c1 = rs * -1.44269504089f, rs2 = rs * rs;
                f32x2_t hv[4];
#pragma unroll
                for (int n = 0; n < 2; ++n)
#pragma unroll
                    for (int q = 0; q < 2; ++q) {
                        const f32x2_t g2 = {acc[ai][0][m][n][2 * q], acc[ai][0][m][n][2 * q + 1]}, u2 = {acc[ai][1][m][n][2 * q], acc[ai][1][m][n][2 * q + 1]};
                        const f32x2_t a = g2 * c1; f32x2_t e; e.x = __builtin_amdgcn_exp2f(a.x); e.y = __builtin_amdgcn_exp2f(a.y);
                        const f32x2_t d = e + 1.0f; f32x2_t r; r.x = __builtin_amdgcn_rcpf(d.x); r.y = __builtin_amdgcn_rcpf(d.y);
                        hv[n * 2 + q] = (g2 * u2) * (r * rs2);
                    }
                u32x4 w; w.x = cvt_pk_bf16(hv[0].x, hv[0].y); w.y = cvt_pk_bf16(hv[1].x, hv[1].y); w.z = cvt_pk_bf16(hv[2].x, hv[2].y); w.w = cvt_pk_bf16(hv[3].x, hv[3].y);
                *(u32x4*)(H + (size_t)row * DFF + col0) = w;
            }
    }
};
template <bool BASE_F32> struct EpiResid {
    static constexpr bool PERM = true, STAGGER = false;
    const float* base_lo; const float* base_hi;
    bf16_t* xb; float* ss_out; float alpha;
    __device__ __forceinline__ void operator()(const f32x4 (&acc)[2][2][4][2], const Unit& u, int wr, int wc, int fr, int fq) const {
        const int row0 = u.pm * BM + wr * 64 + fr, col0 = u.pn * BM + wc * 32 + 8 * fq;
#pragma unroll
        for (int ai = 0; ai < 2; ++ai) {
            f32x4 bf[BASE_F32 ? 4 : 1][2][2]; u32x4 bh[BASE_F32 ? 1 : 4][2];
#pragma unroll
            for (int m = 0; m < 4; ++m) {
                const int row = row0 + ai * HALF + m * 16;
                if (BASE_F32) {
                    const float* bp = (row < T_PROMPT ? base_lo + (size_t)row * DM : base_hi + (size_t)(row - T_PROMPT) * DM) + col0;
#pragma unroll
                    for (int bj = 0; bj < 2; ++bj)
#pragma unroll
                        for (int n = 0; n < 2; ++n) bf[BASE_F32 ? m : 0][bj][n] = *(const f32x4*)(bp + bj * HALF + n * 4);
                } else {
                    const bf16_t* xp = xb + (size_t)row * DM + col0;
#pragma unroll
                    for (int bj = 0; bj < 2; ++bj) bh[BASE_F32 ? 0 : m][bj] = *(const u32x4*)(xp + bj * HALF);
                }
            }
            asm volatile("" ::: "memory");
#pragma unroll
            for (int m = 0; m < 4; ++m) {
                const int row = row0 + ai * HALF + m * 16;
                bf16_t* xp = xb + (size_t)row * DM + col0;
                float sq = 0.f;
#pragma unroll
                for (int bj = 0; bj < 2; ++bj) {
                    f32x4 b0, b1;
                    if (BASE_F32) { b0 = bf[BASE_F32 ? m : 0][bj][0]; b1 = bf[BASE_F32 ? m : 0][bj][1]; }
                    else { const u32x4 v = bh[BASE_F32 ? 0 : m][bj]; b0 = (f32x4){bf_lo(v.x), bf_hi(v.x), bf_lo(v.y), bf_hi(v.y)}; b1 = (f32x4){bf_lo(v.z), bf_hi(v.z), bf_lo(v.w), bf_hi(v.w)}; }
                    const f32x4 o0 = b0 + acc[ai][bj][m][0] * alpha, o1 = b1 + acc[ai][bj][m][1] * alpha;
                    u32x4 w; w.x = cvt_pk_bf16(o0[0], o0[1]); w.y = cvt_pk_bf16(o0[2], o0[3]); w.z = cvt_pk_bf16(o1[0], o1[1]); w.w = cvt_pk_bf16(o1[2], o1[3]);
                    *(u32x4*)(xp + bj * HALF) = w;
                    sq += ((o0[0] * o0[0] + o0[1] * o0[1]) + (o0[2] * o0[2] + o0[3] * o0[3])) + ((o1[0] * o1[0] + o1[1] * o1[1]) + (o1[2] * o1[2] + o1[3] * o1[3]));
                }
                sq += __shfl_xor(sq, 16); sq += __shfl_xor(sq, 32);
                if (fq == 0) ss_out[(size_t)row * 16 + u.pn * 4 + wc] = sq;
            }
        }
    }
};
struct EpiFinal {
    static constexpr bool PERM = true, STAGGER = false;
    const bf16_t* xb; float* out; const float* gain; float* xslot; unsigned* cnt; float alpha; LAS unsigned char* xl;
    __device__ __forceinline__ void operator()(f32x4 (&acc)[2][2][4][2], const Unit& u, int wr, int wc, int fr, int fq) const {
        LAS float* PL = (LAS float*)xl;
        LAS float* SL = (LAS float*)(xl + 4096);
        const int tid = threadIdx.x, lane = tid & 63, wid = __builtin_amdgcn_readfirstlane(tid >> 6);
        const int row0 = u.pm * BM + wr * 64 + fr, col0 = u.pn * BM + wc * 32 + 8 * fq;
#pragma unroll
        for (int ai = 0; ai < 2; ++ai)
#pragma unroll
            for (int m = 0; m < 4; ++m) {
                const int row = row0 + ai * HALF + m * 16;
                const bf16_t* xp = xb + (size_t)row * DM + col0;
                float sq = 0.f;
#pragma unroll
                for (int bj = 0; bj < 2; ++bj) {
                    const u32x4 v = *(const u32x4*)(xp + bj * HALF);
                    const f32x4 o0 = (f32x4){bf_lo(v.x), bf_hi(v.x), bf_lo(v.y), bf_hi(v.y)} + acc[ai][bj][m][0] * alpha;
                    const f32x4 o1 = (f32x4){bf_lo(v.z), bf_hi(v.z), bf_lo(v.w), bf_hi(v.w)} + acc[ai][bj][m][1] * alpha;
                    acc[ai][bj][m][0] = o0; acc[ai][bj][m][1] = o1;
                    sq += ((o0[0] * o0[0] + o0[1] * o0[1]) + (o0[2] * o0[2] + o0[3] * o0[3])) + ((o1[0] * o1[0] + o1[1] * o1[1]) + (o1[2] * o1[2] + o1[3] * o1[3]));
                }
                sq += __shfl_xor(sq, 16); sq += __shfl_xor(sq, 32);
                if (fq == 0) PL[(ai * HALF + wr * 64 + m * 16 + fr) * 4 + wc] = sq;
            }
        asm volatile("s_waitcnt lgkmcnt(0)" ::: "memory"); __builtin_amdgcn_s_barrier(); asm volatile("" ::: "memory");
        if (tid < 256) {
            const f32x4 v = *(const LAS f32x4*)(PL + tid * 4);
            __hip_atomic_store(xslot + (size_t)(u.pm * BM + tid) * 16 + u.pn, (v[0] + v[1]) + (v[2] + v[3]), __ATOMIC_RELAXED, __HIP_MEMORY_SCOPE_AGENT);
        }
        asm volatile("s_waitcnt vmcnt(0)" ::: "memory");
        if (wid < 4 && lane == 0) __hip_atomic_fetch_add(cnt + u.pm, 1u, __ATOMIC_RELAXED, __HIP_MEMORY_SCOPE_AGENT);
        if (wid == 0) {
            unsigned sp = 0;
            while ((unsigned)__builtin_amdgcn_readfirstlane(__hip_atomic_load(cnt + u.pm, __ATOMIC_RELAXED, __HIP_MEMORY_SCOPE_AGENT)) < 16u) { __builtin_amdgcn_s_sleep(2); if (++sp > (1u << 20)) break; }
            __builtin_amdgcn_fence(__ATOMIC_ACQUIRE, "agent");
            asm volatile("s_waitcnt vmcnt(0)" ::: "memory");
        }
        asm volatile("s_waitcnt vmcnt(0) lgkmcnt(0)" ::: "memory"); __builtin_amdgcn_s_barrier(); asm volatile("" ::: "memory");
        if (tid < 256) {
            const float* sl = xslot + (size_t)(u.pm * BM + tid) * 16;
            const float t = (__hip_atomic_load(sl + 0, __ATOMIC_RELAXED, __HIP_MEMORY_SCOPE_AGENT) + __hip_atomic_load(sl + 1, __ATOMIC_RELAXED, __HIP_MEMORY_SCOPE_AGENT))
                          + (__hip_atomic_load(sl + 2, __ATOMIC_RELAXED, __HIP_MEMORY_SCOPE_AGENT) + __hip_atomic_load(sl + 3, __ATOMIC_RELAXED, __HIP_MEMORY_SCOPE_AGENT));
            SL[tid] = rsqrtf(t * (1.0f / DM) + EPS);
        }
        asm volatile("s_waitcnt lgkmcnt(0)" ::: "memory"); __builtin_amdgcn_s_barrier(); asm volatile("" ::: "memory");
        f32x4 gv[2][2];
#pragma unroll
        for (int bj = 0; bj < 2; ++bj)
#pragma unroll
            for (int n = 0; n < 2; ++n) gv[bj][n] = *(const f32x4*)(gain + col0 + bj * HALF + n * 4);
#pragma unroll
        for (int ai = 0; ai < 2; ++ai)
#pragma unroll
            for (int m = 0; m < 4; ++m) {
                const int r = ai * HALF + wr * 64 + m * 16 + fr;
                const float rs = SL[r];
                float* op = out + (size_t)(u.pm * BM + r) * DM + col0;
#pragma unroll
                for (int bj = 0; bj < 2; ++bj)
#pragma unroll
                    for (int n = 0; n < 2; ++n) *(f32x4*)(op + bj * HALF + n * 4) = acc[ai][bj][m][n] * rs * gv[bj][n];
            }
    }
};
struct EpiIn {
    static constexpr bool PERM = true, STAGGER = false;
    bf16_t* P; float* R; const float* ss; LAS unsigned char* xl;
    __device__ __forceinline__ void operator()(const f32x4 (&acc)[2][2][4][2], const Unit& u, int wr, int wc, int fr, int fq) const {
        const int row0 = u.pm * BM + wr * 64 + fr; const int pn = u.pn;
        const LAS float* RSL = panel_scales(xl, ss, u.pm);
#pragma unroll
        for (int ai = 0; ai < 2; ++ai)
#pragma unroll
            for (int m = 0; m < 4; ++m) {
                const int row = row0 + ai * HALF + m * 16;
                const float rs = RSL[wr * 64 + fr + ai * HALF + m * 16];
                if (pn < 6 || pn == 10 || pn == 11) {
                    const float sc = (pn == 0) ? rs * 0.125f : rs;
                    const int cbase = (pn < 6 ? pn * 256 : PB + (pn - 10) * 256) + wc * 32 + 8 * fq;
#pragma unroll
                    for (int bj = 0; bj < 2; ++bj) {
                        const f32x4 v0 = acc[ai][bj][m][0] * sc, v1 = acc[ai][bj][m][1] * sc;
                        u32x4 w; w.x = cvt_pk_bf16(v0[0], v0[1]); w.y = cvt_pk_bf16(v0[2], v0[3]); w.z = cvt_pk_bf16(v1[0], v1[1]); w.w = cvt_pk_bf16(v1[2], v1[3]);
                        *(u32x4*)(P + (size_t)row * PLD + cbase + bj * HALF) = w;
                    }
                } else if (pn < 10) {
                    const float s2 = rs * rs;
                    const f32x4 v0 = acc[ai][0][m][0] * acc[ai][1][m][0] * s2, v1 = acc[ai][0][m][1] * acc[ai][1][m][1] * s2;
                    u32x4 w; w.x = cvt_pk_bf16(v0[0], v0[1]); w.y = cvt_pk_bf16(v0[2], v0[3]); w.z = cvt_pk_bf16(v1[0], v1[1]); w.w = cvt_pk_bf16(v1[2], v1[3]);
                    *(u32x4*)(P + (size_t)row * PLD + PZ + (pn - 6) * 128 + wc * 32 + 8 * fq) = w;
                } else {
                    if (wc == 0) {
                        *(f32x4*)(R + (size_t)row * 32 + 8 * fq) = acc[ai][0][m][0] * rs;
                        *(f32x4*)(R + (size_t)row * 32 + 8 * fq + 4) = acc[ai][0][m][1] * rs;
                    }
                }
            }
    }
};
}

__device__ __forceinline__ void transpose_item(const float* W, int N, int src_col0, const float* gain, bf16_t* WT, int K, int dst_row0, int k0, LAS float* scr, int lane) {
    const int c = lane & 7;
    if (src_col0 < 0) {
#pragma unroll
        for (int j = 0; j < 4; ++j) { const int n = (lane >> 3) + 8 * j; *(u32x4*)(WT + (size_t)(dst_row0 + n) * K + k0 + 8 * c) = (u32x4){0u, 0u, 0u, 0u}; }
        return;
    }
#pragma unroll 16
    for (int i = 0; i < 32; ++i) { const int kk = 2 * i + (lane >> 5); const float gm = gain ? gain[k0 + kk] : 1.0f; scr[kk * 33 + (lane & 31)] = W[(size_t)(k0 + kk) * N + src_col0 + (lane & 31)] * gm; }
    asm volatile("s_waitcnt lgkmcnt(0)" ::: "memory");
#pragma unroll
    for (int j = 0; j < 4; ++j) { const int n = (lane >> 3) + 8 * j; const LAS float* s = scr + (8 * c) * 33 + n;
        u32x4 o; o.x = cvt_pk_bf16(s[0 * 33], s[1 * 33]); o.y = cvt_pk_bf16(s[2 * 33], s[3 * 33]); o.z = cvt_pk_bf16(s[4 * 33], s[5 * 33]); o.w = cvt_pk_bf16(s[6 * 33], s[7 * 33]);
        *(u32x4*)(WT + (size_t)(dst_row0 + n) * K + k0 + 8 * c) = o; }
    asm volatile("s_waitcnt lgkmcnt(0)" ::: "memory");
}
__device__ __forceinline__ void transpose_matrix_item(int kind, const float* W, const float* W2, int Nsrc, const float* gain, bf16_t* WT, int K, int Ndst, int item, LAS float* scr, int lane) {
    const int nblk = Ndst / 32, kb = item / nblk, nb = item % nblk, n0 = nb * 32, k0 = kb * 64;
    const float* src = W; int col = n0;
    if (kind == 0) { const int tile = n0 >> 8, within = n0 & 255; if (within < 128) { col = tile * 128 + within; } else { src = W2; col = tile * 128 + within - 128; } }
    else if (kind == 2) {
        if (n0 < 1536) col = n0;
        else if (n0 < 2560) { const int tile = (n0 - 1536) >> 8, within = (n0 - 1536) & 255; col = (within < 128) ? 2080 + tile * 128 + within : 2592 + tile * 128 + within - 128; }
        else if (n0 < 3072) col = 1568 + (n0 - 2560);
        else if (n0 < 3104) col = 1536 + (n0 - 3072);
        else col = -1;
    }
    transpose_item(src, Nsrc, col, gain, WT, K, n0, k0, scr, lane);
}
__device__ __forceinline__ float wave_sum(float v) {
#pragma unroll
    for (int o = 1; o < 64; o <<= 1) v += __shfl_xor(v, o);
    return v;
}

__device__ __forceinline__ void p0_prologue(const Params& p, LAS unsigned char* lds) {
    const int tid = threadIdx.x, wave = tid >> 6, lane = tid & 63;
    LAS float* scr = (LAS float*)(lds + wave * 16384);
    const int gw = blockIdx.x * 8 + wave, NGW = gridDim.x * 8;
    unsigned char* ws = p.ws;
    constexpr int I_GU = (DM / 64) * (2 * DFF / 32), I_D = (DFF / 64) * (DM / 32), I_IN = (DM / 64) * (NIN_PAD / 32), I_O = (DM / 64) * (DM / 32);
    constexpr int NITEMS = 2 * I_GU + 2 * I_D + I_IN + I_O;
    for (int it = gw; it < NITEMS; it += NGW) {
        int r = it;
        if (r < I_GU) { transpose_matrix_item(0, p.ffn1_wg, p.ffn1_wu, DFF, p.ffn1_norm, (bf16_t*)(ws + WS_WGU1), DM, 2 * DFF, r, scr, lane); continue; } r -= I_GU;
        if (r < I_GU) { transpose_matrix_item(0, p.ffn2_wg, p.ffn2_wu, DFF, p.ffn2_norm, (bf16_t*)(ws + WS_WGU2), DM, 2 * DFF, r, scr, lane); continue; } r -= I_GU;
        if (r < I_D) { transpose_matrix_item(1, p.ffn1_wd, nullptr, DM, nullptr, (bf16_t*)(ws + WS_WD1), DFF, DM, r, scr, lane); continue; } r -= I_D;
        if (r < I_D) { transpose_matrix_item(1, p.ffn2_wd, nullptr, DM, nullptr, (bf16_t*)(ws + WS_WD2), DFF, DM, r, scr, lane); continue; } r -= I_D;
        if (r < I_IN) { transpose_matrix_item(2, p.w_in, nullptr, 3104, p.mix_norm, (bf16_t*)(ws + WS_WIN), DM, NIN_PAD, r, scr, lane); continue; } r -= I_IN;
        transpose_matrix_item(1, p.w_out, nullptr, DM, nullptr, (bf16_t*)(ws + WS_WOUT), DM, DM, r, scr, lane);
    }
    float* SS = (float*)(ws + WS_SS);
    bf16_t* XB = (bf16_t*)(ws + WS_XB);
    for (int rowb = gw * 8; rowb < T_TOK; rowb += NGW * 8) {
        f32x4 v[8][4];
#pragma unroll
        for (int r = 0; r < 8; ++r) { const int row = rowb + r;
            const float* xr = (row < T_PROMPT) ? p.x_prompt + (size_t)row * DM : p.x_sample + (size_t)(row - T_PROMPT) * DM;
#pragma unroll
            for (int j = 0; j < 4; ++j) v[r][j] = *(const f32x4*)(xr + j * 256 + lane * 4); }
#pragma unroll
        for (int r = 0; r < 8; ++r) { const int row = rowb + r; float s = 0.f;
#pragma unroll
            for (int j = 0; j < 4; ++j) {
                s += (v[r][j][0] * v[r][j][0] + v[r][j][1] * v[r][j][1]) + (v[r][j][2] * v[r][j][2] + v[r][j][3] * v[r][j][3]);
                u32x2 w; w.x = cvt_pk_bf16(v[r][j][0], v[r][j][1]); w.y = cvt_pk_bf16(v[r][j][2], v[r][j][3]);
                *(u32x2*)(XB + (size_t)row * DM + j * 256 + lane * 4) = w;
            }
            s = wave_sum(s);
            if (lane < 16) SS[(size_t)row * 16 + lane] = (lane == 0) ? s : 0.f; }
    }
}

template <int CTRL> __device__ __forceinline__ float dpp0(float v) { return __builtin_bit_cast(float, __builtin_amdgcn_update_dpp(0, __builtin_bit_cast(int, v), CTRL, 0xf, 0xf, true)); }
__device__ __forceinline__ float rdlane(float v, int l) { return __builtin_bit_cast(float, __builtin_amdgcn_readlane(__builtin_bit_cast(int, v), l)); }
template <int CTRL, int RMASK> __device__ __forceinline__ float dppm(float v) { return __builtin_bit_cast(float, __builtin_amdgcn_update_dpp(0, __builtin_bit_cast(int, v), CTRL, RMASK, 0xf, false)); }
template <int DIR> __device__ __forceinline__ float lane_scan(float x, int lane, float& tot) {
    float v = x;
    v += dpp0<0x111>(v); v += dpp0<0x112>(v); v += dpp0<0x114>(v); v += dpp0<0x118>(v);
    v += dppm<0x142, 0xa>(v);
    v += dppm<0x143, 0xc>(v);
    tot = rdlane(v, 63);
    return DIR == 0 ? v : (tot - v) + x;
}
__device__ __forceinline__ float log_sigmoid_f(float z) { return fminf(z, 0.f) - 0.69314718056f * __builtin_amdgcn_logf(1.0f + __expf(-fabsf(z))); }

#define LDS_BARRIER() do { asm volatile("s_waitcnt lgkmcnt(0)" ::: "memory"); __builtin_amdgcn_s_barrier(); asm volatile("" ::: "memory"); } while (0)
constexpr int LD72 = 72, LDV = 136, LDR = 36;
constexpr int L_GW = 0, L_GB = 32768, L_RAWQ = 34816, L_RAWK = L_RAWQ + 64 * LD72 * 2, L_RAWV = L_RAWK + 64 * LD72 * 2, L_RAWR = L_RAWV + 64 * LDV * 2,
              L_QD = L_RAWR + 64 * LDR * 4, L_KI = L_QD + 2 * 64 * LD72 * 2, L_VT = L_KI + 2 * 64 * LD72 * 2, L_PP = L_VT + 128 * LD72 * 2, L_SSQ = L_PP + 64 * LD72 * 2, L_GLA_END = L_SSQ + 2048;
static_assert(L_GLA_END <= 147456 - 64, "GLA LDS map");

struct GlaRaw { u32x4 q, k, v0, v1, r; };
template <bool NEED_Q> __device__ __forceinline__ void gla_raw_load(const Params& p, int chunk, int h, int tid, GlaRaw& g) {
    const int row = tid >> 3, c = tid & 7; const size_t tok = (size_t)chunk * 64 + row;
    const bf16_t* pr = (const bf16_t*)(p.ws + WS_P) + tok * PLD;
    if (NEED_Q) g.q = *(const u32x4*)(pr + PQ + h * 64 + c * 8);
    g.k = *(const u32x4*)(pr + PK + h * 64 + c * 8);
    g.v0 = *(const u32x4*)(pr + PV + h * 128 + c * 8); g.v1 = *(const u32x4*)(pr + PV + h * 128 + 64 + c * 8);
    g.r = *(const u32x4*)((const float*)(p.ws + WS_R) + tok * 32 + c * 4);
}
template <bool NEED_Q> __device__ __forceinline__ void gla_raw_store(LAS unsigned char* lds, int tid, const GlaRaw& g) {
    const int row = tid >> 3, c = tid & 7;
    if (NEED_Q) *(LAS u32x4*)(lds + L_RAWQ + (row * LD72 + c * 8) * 2) = g.q;
    *(LAS u32x4*)(lds + L_RAWK + (row * LD72 + c * 8) * 2) = g.k;
    *(LAS u32x4*)(lds + L_RAWV + (row * LDV + c * 8) * 2) = g.v0; *(LAS u32x4*)(lds + L_RAWV + (row * LDV + 64 + c * 8) * 2) = g.v1;
    *(LAS u32x4*)(lds + L_RAWR + (row * LDR + c * 4) * 4) = g.r;
}
__device__ __forceinline__ void gla_stage_gates(const Params& p, LAS unsigned char* lds, int tid) {
#pragma unroll
    for (int j = 0; j < 4; ++j) { const int i = tid + j * 512;
        const f32x4 v = (i < 1024) ? *(const f32x4*)(p.gfw + (size_t)i * 4) : *(const f32x4*)(p.gbw + (size_t)(i - 1024) * 4);
        *(LAS f32x4*)(lds + L_GW + i * 16) = v; }
    if (tid < 128) { const f32x4 v = (tid < 64) ? *(const f32x4*)(p.gfb + tid * 4) : *(const f32x4*)(p.gbb + (tid - 64) * 4); *(LAS f32x4*)(lds + L_GB + tid * 16) = v; }
}

template <int MODE, int DIR> __device__ __forceinline__ void gla_prep(const Params& p, LAS unsigned char* lds, int chunk, int h, int w, int lane) {
    constexpr int dir = DIR; const int dg = w & 3;
    LAS bf16_t* VT = (LAS bf16_t*)(lds + L_VT);
    float rr[16];
#pragma unroll
    for (int j = 0; j < 4; ++j) { const f32x4 v = *(const LAS f32x4*)(lds + L_RAWR + (lane * LDR + dir * 16 + j * 4) * 4); rr[j * 4 + 0] = v[0]; rr[j * 4 + 1] = v[1]; rr[j * 4 + 2] = v[2]; rr[j * 4 + 3] = v[3]; }
    const u32x4 k0 = *(const LAS u32x4*)(lds + L_RAWK + (lane * LD72 + dg * 16) * 2), k1 = *(const LAS u32x4*)(lds + L_RAWK + (lane * LD72 + dg * 16 + 8) * 2);
    const u32x4 v0 = *(const LAS u32x4*)(lds + L_RAWV + (lane * LDV + w * 16) * 2), v1 = *(const LAS u32x4*)(lds + L_RAWV + (lane * LDV + w * 16 + 8) * 2);
    u32x4 q0 = (u32x4){0u, 0u, 0u, 0u}, q1 = q0;
    if (MODE == 1) { q0 = *(const LAS u32x4*)(lds + L_RAWQ + (lane * LD72 + dg * 16) * 2); q1 = *(const LAS u32x4*)(lds + L_RAWQ + (lane * LD72 + dg * 16 + 8) * 2); }
    const unsigned qq[8] = {q0.x, q0.y, q0.z, q0.w, q1.x, q1.y, q1.z, q1.w};
    const unsigned kk[8] = {k0.x, k0.y, k0.z, k0.w, k1.x, k1.y, k1.z, k1.w};
    const unsigned vv[8] = {v0.x, v0.y, v0.z, v0.w, v1.x, v1.y, v1.z, v1.w};
#pragma unroll
    for (int e = 0; e < 8; ++e) { VT[(w * 16 + 2 * e) * LD72 + lane] = (bf16_t)(vv[e] & 0xffffu); VT[(w * 16 + 2 * e + 1) * LD72 + lane] = (bf16_t)(vv[e] >> 16); }
    typedef const __attribute__((address_space(4))) float cfloat; typedef const __attribute__((address_space(4))) f32x4 cf32x4;
    cfloat* gwl = (cfloat*)(DIR ? p.gbw : p.gfw) + h * 64 + dg * 16;
    cfloat* gbl = (cfloat*)(DIR ? p.gbb : p.gfb) + h * 64 + dg * 16;
    float qd[16], ki[16]; float decv = 0.f;
#pragma unroll
    for (int c4 = 0; c4 < 4; ++c4) {
        f32x4 zz = *(cf32x4*)(gbl + c4 * 4);
#pragma unroll
        for (int r = 0; r < 16; ++r) { const f32x4 g = *(cf32x4*)(gwl + r * 256 + c4 * 4); zz = zz + g * rr[r]; }
#pragma unroll
        for (int e = 0; e < 4; ++e) {
            const int cc = c4 * 4 + e;
            const float la = log_sigmoid_f(zz[e]) * (1.0f / 16.0f);
            float tot; const float cum = lane_scan<DIR>(la, lane, tot);
            const float kv = (cc & 1) ? bf_hi(kk[cc >> 1]) : bf_lo(kk[cc >> 1]);
            if (MODE == 0) {
                const float kt = kv * __expf(tot - cum);
                ((LAS bf16_t*)(lds + L_QD))[(dir * 64 + dg * 16 + cc) * LD72 + lane] = (bf16_t)(cvt_pk_bf16(kt, 0.f) & 0xffffu);
                decv = (lane == cc) ? tot : decv;
            } else {
                const float qv = (cc & 1) ? bf_hi(qq[cc >> 1]) : bf_lo(qq[cc >> 1]);
                qd[cc] = qv * __expf(cum); ki[cc] = kv * __expf(-cum);
            }
        }
    }
    if (MODE == 0) { if (lane < 16) ((float*)(p.ws + WS_DEC))[((size_t)(chunk * 4 + h) * 2 + dir) * 64 + dg * 16 + lane] = __expf(decv); }
    if (MODE == 1) {
        LAS bf16_t* QD = (LAS bf16_t*)(lds + L_QD); LAS bf16_t* KI = (LAS bf16_t*)(lds + L_KI);
        u32x4 a, b;
        a.x = cvt_pk_bf16(qd[0], qd[1]); a.y = cvt_pk_bf16(qd[2], qd[3]); a.z = cvt_pk_bf16(qd[4], qd[5]); a.w = cvt_pk_bf16(qd[6], qd[7]);
        b.x = cvt_pk_bf16(qd[8], qd[9]); b.y = cvt_pk_bf16(qd[10], qd[11]); b.z = cvt_pk_bf16(qd[12], qd[13]); b.w = cvt_pk_bf16(qd[14], qd[15]);
        *(LAS u32x4*)(QD + (dir * 64 + lane) * LD72 + dg * 16) = a; *(LAS u32x4*)(QD + (dir * 64 + lane) * LD72 + dg * 16 + 8) = b;
        a.x = cvt_pk_bf16(ki[0], ki[1]); a.y = cvt_pk_bf16(ki[2], ki[3]); a.z = cvt_pk_bf16(ki[4], ki[5]); a.w = cvt_pk_bf16(ki[6], ki[7]);
        b.x = cvt_pk_bf16(ki[8], ki[9]); b.y = cvt_pk_bf16(ki[10], ki[11]); b.z = cvt_pk_bf16(ki[12], ki[13]); b.w = cvt_pk_bf16(ki[14], ki[15]);
        *(LAS u32x4*)(KI + (dir * 64 + lane) * LD72 + dg * 16) = a; *(LAS u32x4*)(KI + (dir * 64 + lane) * LD72 + dg * 16 + 8) = b;
    }
}

struct ConvW { float w0[8], w1[8], w2[8], gn[8]; };
struct ConvRows { u32x4 zc[2], zm[2], zp[2], bb[2]; };
__device__ __forceinline__ void conv_weights(const Params& p, int tid, ConvW& W) {
    const int ch0 = (tid & 63) * 8;
#pragma unroll
    for (int j = 0; j < 2; ++j) {
        const f32x4 a = *(const f32x4*)(p.conv_w + ch0 + j * 4), b = *(const f32x4*)(p.conv_w + 512 + ch0 + j * 4), c = *(const f32x4*)(p.conv_w + 1024 + ch0 + j * 4), g = *(const f32x4*)(p.conv_norm + ch0 + j * 4);
#pragma unroll
        for (int e = 0; e < 4; ++e) { W.w0[j * 4 + e] = a[e]; W.w1[j * 4 + e] = b[e]; W.w2[j * 4 + e] = c[e]; W.gn[j * 4 + e] = g[e]; }
    }
}
__device__ __forceinline__ void conv_load2(const Params& p, int chunk, int k0, int tid, ConvRows& R) {
    const bf16_t* P = (const bf16_t*)(p.ws + WS_P);
    const int ch0 = (tid & 63) * 8;
#pragma unroll
    for (int k = 0; k < 2; ++k) {
        const int t = chunk * 64 + (tid >> 6) + 8 * (k0 + k);
        const bool first = (t == 0) || (t >= T_PROMPT && ((t - T_PROMPT) & (SAMPLE_LEN - 1)) == 0);
        const bool last = (t == T_PROMPT - 1) || (t >= T_PROMPT && ((t - T_PROMPT) & (SAMPLE_LEN - 1)) == SAMPLE_LEN - 1);
        const bf16_t* pr = P + (size_t)t * PLD;
        R.zc[k] = *(const u32x4*)(pr + PZ + ch0);
        R.zm[k] = first ? (u32x4){0u, 0u, 0u, 0u} : *(const u32x4*)(pr - PLD + PZ + ch0);
        R.zp[k] = last ? (u32x4){0u, 0u, 0u, 0u} : *(const u32x4*)(pr + PLD + PZ + ch0);
        R.bb[k] = *(const u32x4*)(pr + PB + ch0);
    }
}
__device__ __forceinline__ void conv_finish2(const Params& p, int chunk, int k0, int tid, const ConvRows& R, const ConvW& W) {
    bf16_t* MIX = (bf16_t*)(p.ws + WS_MIX);
    const int ch0 = (tid & 63) * 8;
#pragma unroll
    for (int k = 0; k < 2; ++k) {
        const int t = chunk * 64 + (tid >> 6) + 8 * (k0 + k);
        float y[8]; float sq = 0.f;
#pragma unroll
        for (int e = 0; e < 4; ++e) {
            const float c0 = bf_lo(R.zm[k][e]) * W.w0[2 * e] + bf_lo(R.zc[k][e]) * W.w1[2 * e] + bf_lo(R.zp[k][e]) * W.w2[2 * e];
            const float c1 = bf_hi(R.zm[k][e]) * W.w0[2 * e + 1] + bf_hi(R.zc[k][e]) * W.w1[2 * e + 1] + bf_hi(R.zp[k][e]) * W.w2[2 * e + 1];
            y[2 * e] = bf_lo(R.bb[k][e]) * c0; y[2 * e + 1] = bf_hi(R.bb[k][e]) * c1;
            sq += y[2 * e] * y[2 * e] + y[2 * e + 1] * y[2 * e + 1];
        }
        sq += __shfl_xor(sq, 1); sq += __shfl_xor(sq, 2); sq += __shfl_xor(sq, 4);
        const float rn = rsqrtf(sq * (1.0f / 64.0f) + EPS);
        u32x4 o;
        o.x = cvt_pk_bf16(y[0] * rn * W.gn[0], y[1] * rn * W.gn[1]); o.y = cvt_pk_bf16(y[2] * rn * W.gn[2], y[3] * rn * W.gn[3]);
        o.z = cvt_pk_bf16(y[4] * rn * W.gn[4], y[5] * rn * W.gn[5]); o.w = cvt_pk_bf16(y[6] * rn * W.gn[6], y[7] * rn * W.gn[7]);
        *(u32x4*)(MIX + (size_t)t * DM + 512 + ch0) = o;
    }
}

__device__ __forceinline__ void p4_gla_phase(const Params& p, LAS unsigned char* lds) {
    const int tid = threadIdx.x, w = __builtin_amdgcn_readfirstlane(tid >> 6), lane = tid & 63, dir = w >> 2, dg = w & 3, fr = lane & 15, fq = lane >> 4;
    const int G = gridDim.x, NIT = NCHUNK * 4;
    int it = blockIdx.x;
    ConvW CW; conv_weights(p, tid, CW);
    int cs = 0; const int ncs = (blockIdx.x < NCHUNK) ? 8 * ((NCHUNK - 1 - (int)blockIdx.x) / G + 1) : 0;
    if (it < NIT) {
    GlaRaw raw; gla_raw_load<false>(p, it >> 2, it & 3, tid, raw);
    LAS bf16_t* KT = (LAS bf16_t*)(lds + L_QD); LAS bf16_t* VT = (LAS bf16_t*)(lds + L_VT);
    bf16_t* ST = (bf16_t*)(p.ws + WS_ST);
    for (; it < NIT; it += G) {
        const int chunk = it >> 2, h = it & 3;
        gla_raw_store<false>(lds, tid, raw);
        LDS_BARRIER();
        if (it + G < NIT) gla_raw_load<false>(p, (it + G) >> 2, (it + G) & 3, tid, raw);
        const bool cv = cs < ncs; ConvRows CR;
        if (cv) conv_load2(p, (int)blockIdx.x + (cs >> 3) * G, cs & 7, tid, CR);
        if (w < 4) gla_prep<0, 0>(p, lds, chunk, h, w, lane); else gla_prep<0, 1>(p, lds, chunk, h, w, lane);
        LDS_BARRIER();
        f32x4 acc[4][2];
#pragma unroll
        for (int mt = 0; mt < 4; ++mt)
#pragma unroll
            for (int nn = 0; nn < 2; ++nn) acc[mt][nn] = (f32x4){0.f, 0.f, 0.f, 0.f};
#pragma unroll
        for (int ks = 0; ks < 2; ++ks) {
            bf16x8 a[4], b[2];
#pragma unroll
            for (int mt = 0; mt < 4; ++mt) a[mt] = *(const LAS bf16x8*)(KT + (dir * 64 + mt * 16 + fr) * LD72 + ks * 32 + fq * 8);
#pragma unroll
            for (int nn = 0; nn < 2; ++nn) b[nn] = *(const LAS bf16x8*)(VT + ((dg * 2 + nn) * 16 + fr) * LD72 + ks * 32 + fq * 8);
#pragma unroll
            for (int mt = 0; mt < 4; ++mt)
#pragma unroll
                for (int nn = 0; nn < 2; ++nn) acc[mt][nn] = __builtin_amdgcn_mfma_f32_16x16x32_bf16(a[mt], b[nn], acc[mt][nn], 0, 0, 0);
        }
        bf16_t* sb = ST + ((size_t)(chunk * 4 + h) * 2 + dir) * 8192;
#pragma unroll
        for (int mt = 0; mt < 4; ++mt)
#pragma unroll
            for (int nn = 0; nn < 2; ++nn) {
                const int dv = (dg * 2 + nn) * 16 + fr, dk0 = mt * 16 + 4 * fq;
                u32x2 o; o.x = cvt_pk_bf16(acc[mt][nn][0], acc[mt][nn][1]); o.y = cvt_pk_bf16(acc[mt][nn][2], acc[mt][nn][3]);
                *(u32x2*)(sb + dv * 64 + dk0) = o;
            }
        if (cv) { conv_finish2(p, (int)blockIdx.x + (cs >> 3) * G, cs & 7, tid, CR, CW); cs += 2; }
    }
    }
    for (; cs < ncs; cs += 2) { ConvRows CR; conv_load2(p, (int)blockIdx.x + (cs >> 3) * G, cs & 7, tid, CR); conv_finish2(p, (int)blockIdx.x + (cs >> 3) * G, cs & 7, tid, CR, CW); }
}

__device__ __forceinline__ void p6_gla_phase(const Params& p, LAS unsigned char* lds) {
    const int tid = threadIdx.x, w = __builtin_amdgcn_readfirstlane(tid >> 6), lane = tid & 63, fr = lane & 15, fq = lane >> 4;
    const int G = gridDim.x, NIT = NCHUNK * 4;
    int it = blockIdx.x; if (it >= NIT) return;
    GlaRaw raw; gla_raw_load<true>(p, it >> 2, it & 3, tid, raw);
    LAS bf16_t* QD = (LAS bf16_t*)(lds + L_QD); LAS bf16_t* KI = (LAS bf16_t*)(lds + L_KI); LAS bf16_t* VT = (LAS bf16_t*)(lds + L_VT); LAS bf16_t* PP = (LAS bf16_t*)(lds + L_PP);
    LAS float* SSQ = (LAS float*)(lds + L_SSQ);
    const bf16_t* P = (const bf16_t*)(p.ws + WS_P);
    const bf16_t* ST = (const bf16_t*)(p.ws + WS_ST);
    bf16_t* MIX = (bf16_t*)(p.ws + WS_MIX);
    const int ti = w & 3, hf = w >> 2;
    for (; it < NIT; it += G) {
        const int chunk = it >> 2, h = it & 3;
        gla_raw_store<true>(lds, tid, raw);
        LDS_BARRIER();
        if (it + G < NIT) gla_raw_load<true>(p, (it + G) >> 2, (it + G) & 3, tid, raw);
        bf16x8 sfr[2][2];
#pragma unroll
        for (int d2 = 0; d2 < 2; ++d2) { const bf16_t* sbase = ST + ((size_t)(chunk * 4 + h) * 2 + d2) * 8192;
#pragma unroll
            for (int ks = 0; ks < 2; ++ks) sfr[d2][ks] = *(const bf16x8*)(sbase + (w * 16 + fr) * 64 + ks * 32 + fq * 8); }
        const int i = ti * 16 + fr;
        const int vcol = h * 128 + w * 16 + 4 * fq;
        u32x2 gv[4];
#pragma unroll
        for (int x = 0; x < 4; ++x) gv[x] = *(const u32x2*)(P + ((size_t)chunk * 64 + x * 16 + fr) * PLD + PG + vcol);
        if (w < 4) gla_prep<1, 0>(p, lds, chunk, h, w, lane); else gla_prep<1, 1>(p, lds, chunk, h, w, lane);
        LDS_BARRIER();
#pragma unroll
        for (int jj = 0; jj < 2; ++jj) {
            const int jt = hf * 2 + jj;
            f32x4 sf = (f32x4){0.f, 0.f, 0.f, 0.f}, sb = (f32x4){0.f, 0.f, 0.f, 0.f};
#pragma unroll
            for (int ks = 0; ks < 2; ++ks) {
                const bf16x8 af = *(const LAS bf16x8*)(KI + (0 * 64 + jt * 16 + fr) * LD72 + ks * 32 + fq * 8);
                const bf16x8 bfw = *(const LAS bf16x8*)(QD + (0 * 64 + ti * 16 + fr) * LD72 + ks * 32 + fq * 8);
                sf = __builtin_amdgcn_mfma_f32_16x16x32_bf16(af, bfw, sf, 0, 0, 0);
                const bf16x8 ab = *(const LAS bf16x8*)(KI + (1 * 64 + jt * 16 + fr) * LD72 + ks * 32 + fq * 8);
                const bf16x8 bb = *(const LAS bf16x8*)(QD + (1 * 64 + ti * 16 + fr) * LD72 + ks * 32 + fq * 8);
                sb = __builtin_amdgcn_mfma_f32_16x16x32_bf16(ab, bb, sb, 0, 0, 0);
            }
            float pv[4];
#pragma unroll
            for (int e = 0; e < 4; ++e) { const int j = jt * 16 + 4 * fq + e; pv[e] = (j <= i ? sf[e] : 0.f) + (j >= i ? sb[e] : 0.f); }
            u32x2 o; o.x = cvt_pk_bf16(pv[0], pv[1]); o.y = cvt_pk_bf16(pv[2], pv[3]);
            *(LAS u32x2*)(PP + i * LD72 + jt * 16 + 4 * fq) = o;
        }
        LDS_BARRIER();
        f32x4 acc[4];
#pragma unroll
        for (int x = 0; x < 4; ++x) acc[x] = (f32x4){0.f, 0.f, 0.f, 0.f};
#pragma unroll
        for (int ks = 0; ks < 2; ++ks) {
            const bf16x8 a = *(const LAS bf16x8*)(VT + (w * 16 + fr) * LD72 + ks * 32 + fq * 8);
#pragma unroll
            for (int x = 0; x < 4; ++x) {
                const bf16x8 b = *(const LAS bf16x8*)(PP + (x * 16 + fr) * LD72 + ks * 32 + fq * 8);
                acc[x] = __builtin_amdgcn_mfma_f32_16x16x32_bf16(a, b, acc[x], 0, 0, 0);
            }
        }
#pragma unroll
        for (int d2 = 0; d2 < 2; ++d2)
#pragma unroll
            for (int ks = 0; ks < 2; ++ks) {
#pragma unroll
                for (int x = 0; x < 4; ++x) {
                    const bf16x8 b = *(const LAS bf16x8*)(QD + (d2 * 64 + x * 16 + fr) * LD72 + ks * 32 + fq * 8);
                    acc[x] = __builtin_amdgcn_mfma_f32_16x16x32_bf16(sfr[d2][ks], b, acc[x], 0, 0, 0);
                }
            }
#pragma unroll
        for (int x = 0; x < 4; ++x) {
            float sq = (acc[x][0] * acc[x][0] + acc[x][1] * acc[x][1]) + (acc[x][2] * acc[x][2] + acc[x][3] * acc[x][3]);
            sq += __shfl_xor(sq, 16); sq += __shfl_xor(sq, 32);
            if (fq == 0) SSQ[w * 64 + x * 16 + fr] = sq;
        }
        LDS_BARRIER();
        const f32x4 hn = *(const f32x4*)(p.gla_norm + vcol);
#pragma unroll
        for (int x = 0; x < 4; ++x) {
            const int tk = x * 16 + fr; float tot = 0.f;
#pragma unroll
            for (int ww = 0; ww < 8; ++ww) tot += SSQ[ww * 64 + tk];
            const float rn = rsqrtf(tot * (1.0f / 128.0f) + EPS);
            const float o0 = acc[x][0] * rn * hn[0] * silu_f(bf_lo(gv[x].x)), o1 = acc[x][1] * rn * hn[1] * silu_f(bf_hi(gv[x].x));
            const float o2 = acc[x][2] * rn * hn[2] * silu_f(bf_lo(gv[x].y)), o3 = acc[x][3] * rn * hn[3] * silu_f(bf_hi(gv[x].y));
            u32x2 o; o.x = cvt_pk_bf16(o0, o1); o.y = cvt_pk_bf16(o2, o3);
            *(u32x2*)(MIX + ((size_t)chunk * 64 + tk) * DM + vcol) = o;
        }
    }
}

template <int EPT, int UB> struct ScanBatch { u32x4 x8[EPT == 8 ? UB : 1]; f32x4 da[EPT == 8 ? UB : 1], db[EPT == 8 ? UB : 1]; bf16_t x1[EPT == 1 ? UB : 1]; float d1[EPT == 1 ? UB : 1]; };
template <int EPT, int UB> __device__ __forceinline__ void scan_load(ScanBatch<EPT, UB>& B, const bf16_t* sp, const float* dp, long cs, long ds, int n0) {
#pragma unroll
    for (int i = 0; i < UB; ++i) {
        if constexpr (EPT == 1) { B.x1[i] = sp[cs * (n0 + i)]; B.d1[i] = dp[ds * (n0 + i)]; }
        else { B.x8[i] = *(const u32x4*)(sp + cs * (n0 + i)); B.da[i] = *(const f32x4*)(dp + ds * (n0 + i)); B.db[i] = *(const f32x4*)(dp + ds * (n0 + i) + 4); }
    }
}
template <int EPT, int UB> __device__ __forceinline__ void scan_step(const ScanBatch<EPT, UB>& B, float (&S)[EPT], bf16_t* sp, long cs, int n0) {
#pragma unroll
    for (int i = 0; i < UB; ++i) {
        if constexpr (EPT == 1) { sp[cs * (n0 + i)] = (bf16_t)(cvt_pk_bf16(S[0], 0.f) & 0xffffu); S[0] = B.d1[i] * S[0] + __uint_as_float(((unsigned)B.x1[i]) << 16); }
        else {
            u32x4 o; o.x = cvt_pk_bf16(S[0], S[1]); o.y = cvt_pk_bf16(S[2], S[3]); o.z = cvt_pk_bf16(S[4], S[5]); o.w = cvt_pk_bf16(S[6], S[7]);
            *(u32x4*)(sp + cs * (n0 + i)) = o;
            S[0] = B.da[i][0] * S[0] + bf_lo(B.x8[i].x); S[1] = B.da[i][1] * S[1] + bf_hi(B.x8[i].x); S[2] = B.da[i][2] * S[2] + bf_lo(B.x8[i].y); S[3] = B.da[i][3] * S[3] + bf_hi(B.x8[i].y);
            S[4] = B.db[i][0] * S[4] + bf_lo(B.x8[i].z); S[5] = B.db[i][1] * S[5] + bf_hi(B.x8[i].z); S[6] = B.db[i][2] * S[6] + bf_lo(B.x8[i].w); S[7] = B.db[i][3] * S[7] + bf_hi(B.x8[i].w);
        }
    }
}
template <int EPT, int UB>
__device__ __forceinline__ void p5_scan(bf16_t* ST, const float* DEC, int head, int dir, int c_first, int nchunks, int e0) {
    const long sgn = dir ? -1 : 1; const long cs = sgn * (4 * 2 * 8192), ds = sgn * (4 * 2 * 64);
    const int c0 = dir ? c_first + nchunks - 1 : c_first;
    bf16_t* sp = ST + ((size_t)(c0 * 4 + head) * 2 + dir) * 8192 + e0;
    const float* dp = DEC + ((size_t)(c0 * 4 + head) * 2 + dir) * 64 + (e0 & 63);
    float S[EPT];
#pragma unroll
    for (int e = 0; e < EPT; ++e) S[e] = 0.f;
    ScanBatch<EPT, UB> A, B;
    scan_load<EPT, UB>(A, sp, dp, cs, ds, 0);
    for (int n0 = 0; n0 < nchunks; n0 += 2 * UB) {
        scan_load<EPT, UB>(B, sp, dp, cs, ds, n0 + UB);
        scan_step<EPT, UB>(A, S, sp, cs, n0);
        if (n0 + 2 * UB < nchunks) scan_load<EPT, UB>(A, sp, dp, cs, ds, n0 + 2 * UB);
        scan_step<EPT, UB>(B, S, sp, cs, n0 + UB);
    }
}

#define XB_TMO      128
#define XB_XCNT(j)  (256  + 64 * (j))
#define XB_XSUB(j)  (1280 + 64 * (j))
#define XB_XGEN(j)  (2304 + 64 * (j))
#define XB_TOP      3328
#define XB_TOPGEN   3392
#define XCD_BAR_WORDS 3456
#define XB_SPIN_CAP (1u << 18)
__device__ __forceinline__ unsigned xb_ld(unsigned* p)              { return __hip_atomic_load(p, __ATOMIC_RELAXED, __HIP_MEMORY_SCOPE_AGENT); }
__device__ __forceinline__ unsigned xb_add(unsigned* p, unsigned v) { return __hip_atomic_fetch_add(p, v, __ATOMIC_RELAXED, __HIP_MEMORY_SCOPE_AGENT); }
__device__ __forceinline__ unsigned xb_xcc_id() { return (unsigned)__builtin_amdgcn_s_getreg((3 << 11) | 20) & 0xFu; }
#define XB_SPIN(cond, bar) do { unsigned _sp = 0; while (cond) { __builtin_amdgcn_s_sleep(1); \
    if ((++_sp & 255u) == 0u) { if (xb_ld(&(bar)[XB_TMO])) break; if (_sp > XB_SPIN_CAP) { atomicAdd(&(bar)[XB_TMO], 1u); break; } } } } while (0)
struct XcdBarrier { unsigned* bar; unsigned x; volatile LAS unsigned* st; };
__device__ __forceinline__ XcdBarrier xcd_barrier_post(unsigned* bar, volatile LAS unsigned* st) {
    XcdBarrier b; b.bar = bar; b.x = xb_xcc_id(); b.st = st;
    if (threadIdx.x == 0) (void)xb_add(&bar[XB_XCNT(b.x)], 1u);
    return b;
}
__device__ __forceinline__ void xcd_barrier_complete(unsigned* bar, unsigned x, unsigned& nloc, unsigned& nx) {
    const unsigned G = gridDim.x * gridDim.y * gridDim.z;
    unsigned sum, cnt, mine, sp = 0u;
    for (;;) {
        sum = 0u; cnt = 0u; mine = 0u;
#pragma unroll
        for (unsigned j = 0; j < 16; ++j) { const unsigned c = xb_ld(&bar[XB_XCNT(j)]); sum += c; cnt += (c > 0u) ? 1u : 0u; mine = (j == x) ? c : mine; }
        if (sum == G) break;
        __builtin_amdgcn_s_sleep(1);
        if ((++sp & 255u) == 0u) { if (xb_ld(&bar[XB_TMO])) break; if (sp > XB_SPIN_CAP) { atomicAdd(&bar[XB_TMO], 1u); break; } }
    }
    nloc = mine > 0u ? mine : 1u; nx = cnt > 0u ? cnt : 1u;
}
__device__ __forceinline__ void xcd_barrier(const XcdBarrier& b) {
    asm volatile("s_waitcnt vmcnt(0)" ::: "memory");
    __syncthreads();
    if (threadIdx.x == 0) {
        unsigned* bar = b.bar;
        __builtin_amdgcn_s_waitcnt(0);
        unsigned nloc = b.st[0], nx = b.st[1];
        if (nloc == 0u) { xcd_barrier_complete(bar, b.x, nloc, nx); b.st[0] = nloc; b.st[1] = nx; }
        const unsigned old = xb_add(&bar[XB_XSUB(b.x)], 1u);
        const unsigned gen = old / nloc;
        if (old + 1u == (gen + 1u) * nloc) {
            __builtin_amdgcn_fence(__ATOMIC_RELEASE, "agent");
            asm volatile("s_waitcnt vmcnt(0)" ::: "memory");
            const unsigned og = xb_add(&bar[XB_TOP], 1u);
            const unsigned tg = og / nx;
            if (og + 1u == (tg + 1u) * nx) xb_add(&bar[XB_TOPGEN], 1u);
            else XB_SPIN(xb_ld(&bar[XB_TOPGEN]) == tg, bar);
            __builtin_amdgcn_fence(__ATOMIC_ACQUIRE, "agent");
            xb_add(&bar[XB_XGEN(b.x)], 1u);
            asm volatile("s_waitcnt vmcnt(0)" ::: "memory");
        } else {
            XB_SPIN(xb_ld(&bar[XB_XGEN(b.x)]) == gen, bar);
            __builtin_amdgcn_fence(__ATOMIC_ACQUIRE, "agent");
            asm volatile("s_waitcnt vmcnt(0)" ::: "memory");
        }
    }
    __syncthreads();
}

constexpr int LDS_BYTES = 147456;
__global__ void __launch_bounds__(512, 2) fwd_megakernel(Params p) {
    extern __shared__ __attribute__((aligned(16))) unsigned char lds_raw[];
    LAS unsigned char* lds = (LAS unsigned char*)lds_raw;
    cg::grid_group grid = cg::this_grid();
    unsigned char* ws = p.ws;
    const int G = gridDim.x, bid = blockIdx.x;
    float* SS = (float*)(ws + WS_SS);
    bf16_t* XB = (bf16_t*)(ws + WS_XB);
    bf16_t* HB = (bf16_t*)(ws + WS_H);
    bf16_t* MIX = (bf16_t*)(ws + WS_MIX);
    const int lo = p.ph_lo, hi = p.ph_hi;
    volatile LAS unsigned* bst = (volatile LAS unsigned*)(lds + LDS_BYTES - 64);
    if (threadIdx.x == 0) { bst[0] = 0u; bst[1] = 0u; }
    __syncthreads();
    if (hi == 0x7fffffff) grid.sync();
    XcdBarrier xbar; xbar.bar = (unsigned*)(ws + WS_BAR); xbar.x = 0; xbar.st = bst;
    if (hi - lo > 1) xbar = xcd_barrier_post((unsigned*)(ws + WS_BAR), bst);
#define IN(k) (lo <= (k) && (k) < hi)
#define SEAM(k) do { if (IN(k) && IN((k) + 1)) xcd_barrier(xbar); } while (0)

    if (IN(0)) p0_prologue(p, lds);
    SEAM(0);
    if (IN(1)) {
        pg8::Gemm g{XB, (const bf16_t*)(ws + WS_WGU1), T_TOK, 2 * DFF, DM}; pg8::StaticOrder S; S.init(T_TOK, 2 * DFF, G, bid);
        if (threadIdx.x == 0) *(LAS int*)(lds + 131072 + 8192 + 1024) = -1;
        __syncthreads();
        pg8::EpiSwiglu E{HB, SS, lds + 131072 + 8192};
        pg8::gemm_phase<pg8::EpiSwiglu, pg8::StaticOrder, true, true>(lds, g, S, E);
    }
    SEAM(1);
    if (IN(2)) {
        pg8::Gemm g{HB, (const bf16_t*)(ws + WS_WD1), T_TOK, DM, DFF}; pg8::StaticOrder S; S.init(T_TOK, DM, G, bid);
        pg8::EpiResid<false> E{nullptr, nullptr, XB, SS + (size_t)16 * T_TOK, 0.5f};
        pg8::gemm_phase<pg8::EpiResid<false>, pg8::StaticOrder, true, true>(lds, g, S, E);
    }
    SEAM(2);
    if (IN(3)) {
        pg8::Gemm g{XB, (const bf16_t*)(ws + WS_WIN), T_TOK, NIN_PAD, DM}; pg8::StaticOrder S; S.init(T_TOK, NIN_PAD, G, bid);
        if (threadIdx.x == 0) *(LAS int*)(lds + 131072 + 8192 + 1024) = -1;
        __syncthreads();
        pg8::EpiIn E{(bf16_t*)(ws + WS_P), (float*)(ws + WS_R), SS + (size_t)16 * T_TOK, lds + 131072 + 8192};
        pg8::gemm_phase<pg8::EpiIn, pg8::StaticOrder, true, true>(lds, g, S, E);
    }
    SEAM(3);
    if (IN(4)) {
        p4_gla_phase(p, lds);
    }
    SEAM(4);
    if (IN(5)) {
        bf16_t* ST = (bf16_t*)(ws + WS_ST); const float* DEC = (const float*)(ws + WS_DEC);
        for (int task = bid; task < 256; task += G) {
            if (task < 128) { const int chain = task >> 4, slice = task & 15; p5_scan<1, 16>(ST, DEC, chain >> 1, chain & 1, 0, 256, slice * 512 + (int)threadIdx.x); }
            else { const int idx = task - 128, chain = idx >> 1, half = idx & 1, seq = chain >> 3; p5_scan<8, 4>(ST, DEC, (chain & 7) >> 1, chain & 1, 256 + seq * 32, 32, (half * 512 + (int)threadIdx.x) * 8); }
        }
    }
    SEAM(5);
    if (IN(6)) {
        p6_gla_phase(p, lds);
    }
    SEAM(6);
    if (IN(7)) {
        pg8::Gemm g{MIX, (const bf16_t*)(ws + WS_WOUT), T_TOK, DM, DM}; pg8::StaticOrder S; S.init(T_TOK, DM, G, bid);
        pg8::EpiResid<false> E{nullptr, nullptr, XB, SS + (size_t)32 * T_TOK, 1.0f};
        pg8::gemm_phase<pg8::EpiResid<false>, pg8::StaticOrder, true, true>(lds, g, S, E);
    }
    SEAM(7);
    if (IN(8)) {
        pg8::Gemm g{XB, (const bf16_t*)(ws + WS_WGU2), T_TOK, 2 * DFF, DM}; pg8::StaticOrder S; S.init(T_TOK, 2 * DFF, G, bid);
        if (threadIdx.x == 0) *(LAS int*)(lds + 131072 + 8192 + 1024) = -1;
        __syncthreads();
        pg8::EpiSwiglu E{HB, SS + (size_t)32 * T_TOK, lds + 131072 + 8192};
        pg8::gemm_phase<pg8::EpiSwiglu, pg8::StaticOrder, true, true>(lds, g, S, E);
    }
    SEAM(8);
    if (IN(9)) {
        pg8::Gemm g{HB, (const bf16_t*)(ws + WS_WD2), T_TOK, DM, DFF}; pg8::StaticOrder S; S.init(T_TOK, DM, G, bid);
        pg8::EpiFinal E{XB, p.out, p.final_norm, SS + (size_t)48 * T_TOK, (unsigned*)(ws + WS_BAR) + 3584, 0.5f, lds + 131072};
        pg8::gemm_phase<pg8::EpiFinal, pg8::StaticOrder, true, true>(lds, g, S, E);
    }
#undef IN
#undef SEAM
}

#ifndef PHASE_MASK
#define PHASE_MASK 0x7FF
#endif
#ifndef N_LAUNCH_MODE
#define N_LAUNCH_MODE 1
#endif
extern "C" void kernel_launch(void* const* d_in, const int* in_sizes, int n_in, void* d_out, int out_size, void* d_ws, size_t ws_size, hipStream_t stream) {
    static int grid = 0;
    if (grid == 0) {
        int dev = 0, cus = 0, per_cu = 0;
        if (hipGetDevice(&dev) != hipSuccess || hipDeviceGetAttribute(&cus, hipDeviceAttributeMultiprocessorCount, dev) != hipSuccess) { fprintf(stderr, "device query failed\n"); grid = -1; return; }
        if (hipFuncSetAttribute((const void*)fwd_megakernel, hipFuncAttributeMaxDynamicSharedMemorySize, LDS_BYTES) != hipSuccess) { fprintf(stderr, "hipFuncSetAttribute failed\n"); grid = -1; return; }
        if (hipOccupancyMaxActiveBlocksPerMultiprocessor(&per_cu, (const void*)fwd_megakernel, 512, LDS_BYTES) != hipSuccess || per_cu < 1) { fprintf(stderr, "occupancy query: %d\n", per_cu); per_cu = 1; }
        (void)hipGetLastError();
        grid = cus * per_cu;
        if (n_in != 21 || ws_size < WS_END) { fprintf(stderr, "unexpected n_in %d / ws %zu (need %zu)\n", n_in, ws_size, (size_t)WS_END); grid = -1; return; }
    }
    if (grid < 0) return;
    Params p{};
    const float** pp = (const float**)&p;
    for (int i = 0; i < 21; ++i) pp[i] = (const float*)d_in[i];
    p.out = (float*)d_out; p.ws = (unsigned char*)d_ws;
    if (hipMemsetAsync((char*)d_ws + WS_BAR, 0, 16384, stream) != hipSuccess) { fprintf(stderr, "memset of barrier words failed\n"); return; }
#if N_LAUNCH_MODE == 1
    p.ph_lo = 0; p.ph_hi = 11;
    void* args[] = {&p};
    hipError_t e = hipLaunchCooperativeKernel((const void*)fwd_megakernel, dim3(grid), dim3(512), args, LDS_BYTES, stream);
    if (e != hipSuccess) fprintf(stderr, "cooperative launch failed: %s (grid %d)\n", hipGetErrorString(e), grid);
#else
    for (int k = 0; k < 11; ++k) { if (!((PHASE_MASK >> k) & 1)) continue; p.ph_lo = k; p.ph_hi = k + 1; hipLaunchKernelGGL(fwd_megakernel, dim3(grid), dim3(512), LDS_BYTES, stream, p); }
#endif
}
```
